# Optimizing an MI355X kernel written in HIP

```python
import jax, jax.numpy as jnp
from jax import lax
import numpy as np

D_MODEL = 1024
BATCH = 16
SEQ = 256
DEPTH = 1
DEC_BATCH = 4
DEC_SEQ = 2048
PAST_LEN = 256

GRID_W = 64
RWKV_HEAD_DIM = 64
RWKV_WIDTH = D_MODEL // 2
RWKV_HEADS = RWKV_WIDTH // RWKV_HEAD_DIM
GLA_HEADS = 4
GLA_V_WIDTH = D_MODEL // 2
GLA_VAL_DIM = GLA_V_WIDTH // GLA_HEADS
GLA_QK_WIDTH = GLA_V_WIDTH // 2
GLA_KEY_DIM = GLA_QK_WIDTH // GLA_HEADS
GLA_CHUNK = 32
GLA_GATE_RANK = 16
GLA_GATE_NORMALIZER = 16.0
DECAY_LORA = 64
AAA_LORA = 64
GATE_LORA = 128
D_FF = 4 * D_MODEL
IN_WIDTH = 3 * RWKV_WIDTH + 2 * GLA_QK_WIDTH + 2 * GLA_V_WIDTH
MIX_WIDTH = RWKV_WIDTH + GLA_V_WIDTH
N_MOD = 6
RMS_EPS = 1e-6
LNX_EPS = 64e-5
GLA_NORM_EPS = 1e-5

kernel_name = 'hymba_rwkv7_gla_diffusion_step'


def _rmsnorm(x, g, eps=RMS_EPS):
    xf = x.astype(jnp.float32)
    y = xf * lax.rsqrt(jnp.mean(xf * xf, axis=-1, keepdims=True) + eps)
    return (y * g.astype(jnp.float32)).astype(x.dtype)


def _shift_seq(x):
    xp = jnp.pad(x, ((0, 0), (1, 1), (0, 0)))
    return 0.5 * (xp[:, :-2] + xp[:, 2:])


def _shift_grid(x):
    b, l, ch = x.shape
    rows = l // GRID_W
    g = jnp.pad(x.reshape(b, rows, GRID_W, ch), ((0, 0), (1, 1), (1, 1), (0, 0)))
    nb = g[:, :-2, 1:-1] + g[:, 2:, 1:-1] + g[:, 1:-1, :-2] + g[:, 1:-1, 2:]
    return (0.25 * nb).reshape(b, l, ch)


def _flip(t):
    return jnp.flip(t, axis=1)


def _rwkv7_scan(r, w, k, v, kk, a, s0):
    def step(s, inp):
        r_t, w_t, k_t, v_t, kk_t, a_t = inp
        sa = jnp.einsum('bhij,bhj->bhi', s, -kk_t)
        s = (s * w_t[:, :, None, :] + sa[..., None] * (kk_t * a_t)[:, :, None, :]
             + v_t[..., None] * k_t[:, :, None, :])
        return s, jnp.einsum('bhij,bhj->bhi', s, r_t)
    xs = tuple(jnp.swapaxes(t, 0, 1) for t in (r, w, k, v, kk, a))
    s_fin, ys = lax.scan(step, s0, xs)
    return jnp.swapaxes(ys, 0, 1), s_fin


def _gla_chunked(q, k, v, log_a, s0):
    b, l, h, _ = q.shape
    n = l // GLA_CHUNK

    def chunks(t):
        return t.reshape(b, n, GLA_CHUNK, h, t.shape[-1]).transpose(0, 1, 3, 2, 4)

    q, k, v, log_a = chunks(q), chunks(k), chunks(v), chunks(log_a)
    cum = jnp.cumsum(log_a, axis=3)
    causal = jnp.tril(jnp.ones((GLA_CHUNK, GLA_CHUNK), dtype=bool))[:, :, None]
    diff = cum[..., :, None, :] - cum[..., None, :, :]
    decay = jnp.where(causal, jnp.exp(jnp.where(causal, diff, 0.0)), 0.0)
    att = jnp.sum(q[..., :, None, :] * k[..., None, :, :] * decay, axis=-1)
    o_intra = jnp.einsum('bnhij,bnhjv->bnhiv', att, v)
    last = cum[..., -1:, :]
    q_in = q * jnp.exp(cum)
    k_in = k * jnp.exp(last - cum)
    g_last = jnp.exp(last[..., 0, :])

    def step(s, inp):
        qc, kc, vc, gc = inp
        o = jnp.einsum('bhck,bhkv->bhcv', qc, s)
        s = gc[..., None] * s + jnp.einsum('bhck,bhcv->bhkv', kc, vc)
        return s, o

    xs = tuple(jnp.moveaxis(t, 1, 0) for t in (q_in, k_in, v, g_last))
    s_fin, o_inter = lax.scan(step, s0, xs)
    o = o_intra + jnp.moveaxis(o_inter, 0, 1)
    return o.transpose(0, 1, 3, 2, 4).reshape(b, l, h, v.shape[-1]), s_fin


def _mixer(h, shift, s_rf, s_rb, s_gf, s_gb, p):
    f32 = jnp.float32
    b, l, _ = h.shape
    R = RWKV_WIDTH
    proj = h @ p['w_in']
    rkv, gq, gkey, gv, gg = jnp.split(
        proj, [3 * R, 3 * R + GLA_QK_WIDTH, 3 * R + 2 * GLA_QK_WIDTH,
               3 * R + 2 * GLA_QK_WIDTH + GLA_V_WIDTH], axis=-1)

    rkv = rkv + p['mu_rkv'] * (shift(rkv) - rkv)
    r, k, v = jnp.split(rkv, 3, axis=-1)
    dh = shift(h) - h
    xw = h + p['mu_wag'][0] * dh
    xa = h + p['mu_wag'][1] * dh
    xg = h + p['mu_wag'][2] * dh

    def heads(t):
        return t.astype(f32).reshape(b, l, RWKV_HEADS, RWKV_HEAD_DIM)

    rh, kh, vh = heads(r), heads(k), heads(v)
    kk = kh * p['k_k'].astype(f32).reshape(RWKV_HEADS, RWKV_HEAD_DIM)
    kk = kk * lax.rsqrt(jnp.maximum(jnp.sum(kk * kk, axis=-1, keepdims=True), 1e-12))
    k_a = p['k_a'].astype(f32).reshape(RWKV_HEADS, RWKV_HEAD_DIM)

    def dir_inputs(d):
        z = (p['w0'][d] + jnp.tanh(xw @ p['w1'][d]) @ p['w2'][d]).astype(f32)
        wh = heads(jnp.exp(-jnp.exp(-jax.nn.softplus(-z) - 0.5)))
        ah = heads(jax.nn.sigmoid(p['a0'][d] + (xa @ p['a1'][d]) @ p['a2'][d]))
        kd = kh * (1.0 + (ah - 1.0) * k_a)
        return wh, ah, kd

    w_f, a_f, kd_f = dir_inputs(0)
    w_b, a_b, kd_b = dir_inputs(1)
    y_f, srf = _rwkv7_scan(rh, w_f, kd_f, vh, kk, a_f, s_rf.astype(f32))
    y_b, srb = _rwkv7_scan(_flip(rh), _flip(w_b), _flip(kd_b), _flip(vh), _flip(kk), _flip(a_b),
                           s_rb.astype(f32))
    y = y_f + _flip(y_b)
    mu = jnp.mean(y, axis=-1, keepdims=True)
    var = jnp.mean(jnp.square(y - mu), axis=-1, keepdims=True)
    yn = ((y - mu) * lax.rsqrt(var + LNX_EPS)).reshape(b, l, R)
    yn = yn * p['lnx_g'].astype(f32) + p['lnx_b'].astype(f32)
    bonus = (jnp.sum(rh * (kd_f + kd_b) * p['r_k'].astype(f32), axis=-1, keepdims=True) * vh).reshape(b, l, R)
    gate = (jax.nn.sigmoid(xg @ p['g1']) @ p['g2']).astype(f32)
    rwkv_out = (yn + bonus) * gate

    def gheads(t, dim):
        return t.astype(f32).reshape(b, l, GLA_HEADS, dim)

    q = gheads(gq, GLA_KEY_DIM) * (GLA_KEY_DIM ** -0.5)
    kg = gheads(gkey, GLA_KEY_DIM)
    vg = gheads(gv, GLA_VAL_DIM)

    def log_gate(d):
        logits = ((h @ p['gk1'][d]) @ p['gk2'][d] + p['gk_b'][d]).astype(f32)
        return gheads(jax.nn.log_sigmoid(logits), GLA_KEY_DIM) / GLA_GATE_NORMALIZER

    o_f, sgf = _gla_chunked(q, kg, vg, log_gate(0), s_gf.astype(f32))
    o_b, sgb = _gla_chunked(_flip(q), _flip(kg), _flip(vg), _flip(log_gate(1)), s_gb.astype(f32))
    o = o_f + _flip(o_b)
    o = (o * lax.rsqrt(jnp.mean(o * o, axis=-1, keepdims=True) + GLA_NORM_EPS)
         * p['gla_norm_g'].astype(f32) * jax.nn.silu(gheads(gg, GLA_VAL_DIM)))
    gla_out = o.reshape(b, l, GLA_V_WIDTH)

    out = jnp.concatenate([rwkv_out, gla_out], axis=-1).astype(h.dtype) @ p['w_out']
    return out, (srf, srb, sgf, sgb)


def _block(x, mod, shift, states, p):
    sh1, sc1, gt1, sh2, sc2, gt2 = jnp.split(mod, N_MOD, axis=-1)
    h = _rmsnorm(x, p['norm1_g']) * (1.0 + sc1) + sh1
    o, new_states = _mixer(h, shift, states[0], states[1], states[2], states[3], p)
    x = x + gt1 * o
    h = _rmsnorm(x, p['norm2_g']) * (1.0 + sc2) + sh2
    f = jnp.square(jax.nn.relu(h @ p['mlp_w1'])) @ p['mlp_w2']
    x = x + gt2 * f
    return x, new_states


def setup_inputs(seed: int = 0) -> dict:
    key = jax.random.key(seed)
    ks = iter(jax.random.split(key, 48))

    def nrm(shape, scale):
        return scale * jax.random.normal(next(ks), shape, jnp.float32)

    def unif(shape, lo, hi):
        return jax.random.uniform(next(ks), shape, jnp.float32, lo, hi)

    D = D_MODEL
    R = RWKV_WIDTH
    L = DEPTH
    return {
        'x_prompt': nrm((BATCH, SEQ, D), 1.0),
        'x_sample': nrm((DEC_BATCH, DEC_SEQ, D), 1.0),
        'c': nrm((DEC_BATCH, D), 1.0),
        'state_rwkv_fwd': nrm((DEC_BATCH, L, RWKV_HEADS, RWKV_HEAD_DIM, RWKV_HEAD_DIM), 0.5),
        'state_rwkv_bwd': nrm((DEC_BATCH, L, RWKV_HEADS, RWKV_HEAD_DIM, RWKV_HEAD_DIM), 0.5),
        'state_gla_fwd': nrm((DEC_BATCH, L, GLA_HEADS, GLA_KEY_DIM, GLA_VAL_DIM), 0.5),
        'state_gla_bwd': nrm((DEC_BATCH, L, GLA_HEADS, GLA_KEY_DIM, GLA_VAL_DIM), 0.5),
        'c_ctx': nrm((D,), 1.0),
        'ada_w': nrm((L, D, N_MOD * D), 0.3 * D ** -0.5),
        'ada_b': nrm((L, N_MOD * D), 0.02),
        'norm1_g': 1.0 + nrm((L, D), 0.01),
        'norm2_g': 1.0 + nrm((L, D), 0.01),
        'w_in': nrm((L, D, IN_WIDTH), D ** -0.5),
        'rwkv_mu_rkv': unif((L, 3 * R), 0.2, 0.8),
        'rwkv_mu_wag': unif((L, 3, D), 0.2, 0.8),
        'rwkv_w0': nrm((L, 2, R), 0.5) - 0.5,
        'rwkv_w1': nrm((L, 2, D, DECAY_LORA), D ** -0.5),
        'rwkv_w2': nrm((L, 2, DECAY_LORA, R), 0.3 * DECAY_LORA ** -0.5),
        'rwkv_a0': nrm((L, 2, R), 0.1),
        'rwkv_a1': nrm((L, 2, D, AAA_LORA), D ** -0.5),
        'rwkv_a2': nrm((L, 2, AAA_LORA, R), 0.3 * AAA_LORA ** -0.5),
        'rwkv_g1': nrm((L, D, GATE_LORA), D ** -0.5),
        'rwkv_g2': nrm((L, GATE_LORA, R), GATE_LORA ** -0.5),
        'rwkv_k_k': 0.85 + nrm((L, R), 0.05),
        'rwkv_k_a': 1.0 + nrm((L, R), 0.05),
        'rwkv_r_k': nrm((L, RWKV_HEADS, RWKV_HEAD_DIM), 0.1),
        'rwkv_lnx_g': 1.0 + nrm((L, R), 0.01),
        'rwkv_lnx_b': nrm((L, R), 0.01),
        'gla_gk1': nrm((L, 2, D, GLA_GATE_RANK), D ** -0.5),
        'gla_gk2': nrm((L, 2, GLA_GATE_RANK, GLA_QK_WIDTH), GLA_GATE_RANK ** -0.5),
        'gla_gk_b': nrm((L, 2, GLA_QK_WIDTH), 0.5) + 1.0,
        'gla_norm_g': 1.0 + nrm((L, GLA_VAL_DIM), 0.01),
        'w_out': nrm((L, MIX_WIDTH, D), MIX_WIDTH ** -0.5),
        'mlp_w1': nrm((L, D, D_FF), D ** -0.5),
        'mlp_w2': nrm((L, D_FF, D), D_FF ** -0.5),
        'final_norm_g': 1.0 + nrm((D,), 0.01),
    }


def reference(x_prompt, x_sample, c, state_rwkv_fwd, state_rwkv_bwd, state_gla_fwd, state_gla_bwd,
              c_ctx, ada_w, ada_b, norm1_g, norm2_g, w_in, rwkv_mu_rkv, rwkv_mu_wag,
              rwkv_w0, rwkv_w1, rwkv_w2, rwkv_a0, rwkv_a1, rwkv_a2, rwkv_g1, rwkv_g2,
              rwkv_k_k, rwkv_k_a, rwkv_r_k, rwkv_lnx_g, rwkv_lnx_b,
              gla_gk1, gla_gk2, gla_gk_b, gla_norm_g, w_out, mlp_w1, mlp_w2, final_norm_g):
    f32 = jnp.float32
    nb = x_prompt.shape[0]
    zr = jnp.zeros((nb, RWKV_HEADS, RWKV_HEAD_DIM, RWKV_HEAD_DIM), f32)
    zg = jnp.zeros((nb, GLA_HEADS, GLA_KEY_DIM, GLA_VAL_DIM), f32)
    ctx_cond = jax.nn.silu(c_ctx)
    lat_cond = jax.nn.silu(c)
    xp, xs = x_prompt, x_sample
    new_rf, new_rb, new_gf, new_gb = [], [], [], []
    for layer in range(DEPTH):
        p = {
            'norm1_g': norm1_g[layer], 'norm2_g': norm2_g[layer], 'w_in': w_in[layer],
            'mu_rkv': rwkv_mu_rkv[layer], 'mu_wag': rwkv_mu_wag[layer],
            'w0': rwkv_w0[layer], 'w1': rwkv_w1[layer], 'w2': rwkv_w2[layer],
            'a0': rwkv_a0[layer], 'a1': rwkv_a1[layer], 'a2': rwkv_a2[layer],
            'g1': rwkv_g1[layer], 'g2': rwkv_g2[layer],
            'k_k': rwkv_k_k[layer], 'k_a': rwkv_k_a[layer], 'r_k': rwkv_r_k[layer],
            'lnx_g': rwkv_lnx_g[layer], 'lnx_b': rwkv_lnx_b[layer],
            'gk1': gla_gk1[layer], 'gk2': gla_gk2[layer], 'gk_b': gla_gk_b[layer],
            'gla_norm_g': gla_norm_g[layer], 'w_out': w_out[layer],
            'mlp_w1': mlp_w1[layer], 'mlp_w2': mlp_w2[layer],
        }
        mod_ctx = (ctx_cond @ ada_w[layer] + ada_b[layer])[None, None, :]
        mod_lat = (lat_cond @ ada_w[layer] + ada_b[layer])[:, None, :]
        xp, (srf, srb, sgf, sgb) = _block(xp, mod_ctx, _shift_seq, (zr, zr, zg, zg), p)
        new_rf.append(srf)
        new_rb.append(srb)
        new_gf.append(sgf)
        new_gb.append(sgb)
        xs, _ = _block(xs, mod_lat, _shift_grid,
                       (state_rwkv_fwd[:, layer], state_rwkv_bwd[:, layer],
                        state_gla_fwd[:, layer], state_gla_bwd[:, layer]), p)
    y_prompt = _rmsnorm(xp, final_norm_g)
    y_sample = _rmsnorm(xs, final_norm_g)
    new_state_rwkv_fwd = jnp.stack(new_rf, axis=1).astype(x_prompt.dtype)
    new_state_rwkv_bwd = jnp.stack(new_rb, axis=1).astype(x_prompt.dtype)
    new_state_gla_fwd = jnp.stack(new_gf, axis=1).astype(x_prompt.dtype)
    new_state_gla_bwd = jnp.stack(new_gb, axis=1).astype(x_prompt.dtype)
    return (y_prompt, y_sample, new_state_rwkv_fwd, new_state_rwkv_bwd, new_state_gla_fwd, new_state_gla_bwd)
```

```cpp
#include <hip/hip_runtime.h>
#include <stdint.h>

typedef unsigned short bf16_t;
typedef short bf16x8 __attribute__((ext_vector_type(8)));
typedef float f32x4 __attribute__((ext_vector_type(4)));

constexpr int D = 1024, NB_P = 16, L_P = 256, NB_S = 4, L_S = 2048;
constexpr int M_P = NB_P * L_P, M_S = NB_S * L_S, M = M_P + M_S;
constexpr int RW = 512, NH = 8, HD = 64, GH = 4, GKD = 64, GVD = 128, GQK = 256;
constexpr int FF = 4096, N1 = 4096, LA = 3072, NMOD = 6 * D;
constexpr int GRID_W = 64;
constexpr int C_GQ = 1536, C_GK = 1792, C_GV = 2048, C_GG = 2560;
constexpr int C_PWA = LA, C_PAA = LA + 128, C_PGA = LA + 256, C_PWB = LA + 384, C_PAB = LA + 512, C_PGB = LA + 640, C_PGK = LA + 768;

constexpr size_t MiB = 1u << 20;
constexpr size_t WS_WC1T = 1 * MiB, WS_WOT = 9 * MiB, WS_W1T = 11 * MiB, WS_W2T = 19 * MiB;
constexpr size_t WS_MOD = 27 * MiB;
constexpr size_t WS_XN = 29 * MiB;
constexpr size_t WS_PROJ = 53 * MiB;
constexpr size_t WS_SCAN = 149 * MiB;
constexpr size_t SCAN_STRIDE = (size_t)M * RW;
constexpr size_t DO_LGF = 0, DO_LGB = 6 * MiB, DO_OF = 12 * MiB, DO_OB = 24 * MiB, DO_GATE = 36 * MiB;

__device__ __forceinline__ unsigned f2bf(float f) { unsigned u = __builtin_bit_cast(unsigned, f); return (u + 0x7fffu + ((u >> 16) & 1u)) >> 16; }
__device__ __forceinline__ float bf2f(bf16_t h) { return __builtin_bit_cast(float, (unsigned)h << 16); }
__device__ __forceinline__ float sigmoidf_(float x) { return 1.f / (1.f + __expf(-x)); }
__device__ __forceinline__ float log_sigmoidf_(float x) { return fminf(x, 0.f) - log1pf(__expf(-fabsf(x))); }

struct Tok { int b, t, L, base, modi; bool sample; };
__device__ __forceinline__ Tok tok_of(int m) {
    Tok k;
    if (m < M_P) { k.b = m / L_P; k.t = m % L_P; k.L = L_P; k.base = k.b * L_P; k.modi = 0; k.sample = false; }
    else { int q = m - M_P; k.b = q / L_S; k.t = q % L_S; k.L = L_S; k.base = M_P + k.b * L_S; k.modi = 1 + k.b; k.sample = true; }
    return k;
}
struct Nb { int n0, n1, n2, n3; float wgt; };
__device__ __forceinline__ Nb shift_nb(const Tok& k) {
    Nb r; r.n0 = r.n1 = r.n2 = r.n3 = -1;
    if (!k.sample) { r.wgt = 0.5f; if (k.t > 0) r.n0 = k.base + k.t - 1; if (k.t < k.L - 1) r.n1 = k.base + k.t + 1; }
    else { r.wgt = 0.25f; const int row = k.t / GRID_W, col = k.t % GRID_W;
        if (row > 0) r.n0 = k.base + k.t - GRID_W; if (row < L_S / GRID_W - 1) r.n1 = k.base + k.t + GRID_W;
        if (col > 0) r.n2 = k.base + k.t - 1; if (col < GRID_W - 1) r.n3 = k.base + k.t + 1; }
    return r;
}
__device__ __forceinline__ float nb_sum(const bf16_t* proj, const Nb& nb, int col) {
    float s = 0.f;
    if (nb.n0 >= 0) s += bf2f(proj[(size_t)nb.n0 * N1 + col]);
    if (nb.n1 >= 0) s += bf2f(proj[(size_t)nb.n1 * N1 + col]);
    if (nb.n2 >= 0) s += bf2f(proj[(size_t)nb.n2 * N1 + col]);
    if (nb.n3 >= 0) s += bf2f(proj[(size_t)nb.n3 * N1 + col]);
    return s;
}

__global__ void k_transpose(const float* __restrict__ W, int K, int N, bf16_t* __restrict__ WT) {
    size_t i = (size_t)blockIdx.x * blockDim.x + threadIdx.x; if (i >= (size_t)K * N) return;
    int n = (int)(i % N), k = (int)(i / N);
    WT[(size_t)n * K + k] = (bf16_t)f2bf(W[i]);
}
__global__ void k_fold(const float* __restrict__ mu_wag, const float* __restrict__ w1, const float* __restrict__ a1, const float* __restrict__ g1,
                       const float* __restrict__ gk1, bf16_t* __restrict__ WC1T) {
    int i = blockIdx.x * blockDim.x + threadIdx.x; if (i >= (N1 - LA) * D) return;
    int k = i % D, j = i / D;
    float v = 0.f;
    if (j < 768) {
        int part = j / 128, c = j % 128;
        int which = part % 3; bool bpart = part >= 3;
        float mu = mu_wag[which * D + k]; float f = bpart ? mu : 1.f - mu;
        float w;
        if (which == 0) w = w1[((size_t)(c / 64) * D + k) * 64 + (c % 64)];
        else if (which == 1) w = a1[((size_t)(c / 64) * D + k) * 64 + (c % 64)];
        else w = g1[(size_t)k * 128 + c];
        v = f * w;
    } else if (j < 800) { int c = j - 768; v = gk1[((size_t)(c / 16) * D + k) * 16 + (c % 16)]; }
    WC1T[(size_t)(LA + j) * D + k] = (bf16_t)f2bf(v);
}
__global__ void k_mod(const float* __restrict__ c, const float* __restrict__ c_ctx, const float* __restrict__ ada_w, const float* __restrict__ ada_b, float* __restrict__ mod) {
    int i = blockIdx.x * blockDim.x + threadIdx.x; if (i >= 5 * NMOD) return;
    int b = i / NMOD, col = i % NMOD;
    const float* cv = b == 0 ? c_ctx : c + (size_t)(b - 1) * D;
    float acc = 0.f;
    for (int k = 0; k < D; ++k) { float x = cv[k]; acc += (x * sigmoidf_(x)) * ada_w[(size_t)k * NMOD + col]; }
    mod[i] = acc + ada_b[col];
}
__device__ __forceinline__ float block_sum256(float v, float* sh) {
    for (int o = 1; o < 64; o <<= 1) v += __shfl_xor(v, o);
    __syncthreads();
    if ((threadIdx.x & 63) == 0) sh[threadIdx.x >> 6] = v;
    __syncthreads();
    return sh[0] + sh[1] + sh[2] + sh[3];
}
__global__ void k_norm_mod(const float* __restrict__ xa, const float* __restrict__ xb, const float* __restrict__ g, const float* __restrict__ mod, int sh_off, int sc_off, bf16_t* __restrict__ out) {
    __shared__ float sh[4];
    int m = blockIdx.x; Tok k = tok_of(m);
    const float* x = (xb == nullptr) ? xa + (size_t)m * D : (m < M_P ? xa + (size_t)m * D : xb + (size_t)(m - M_P) * D);
    f32x4 v = *(const f32x4*)(x + threadIdx.x * 4);
    float ss = block_sum256(v.x * v.x + v.y * v.y + v.z * v.z + v.w * v.w, sh);
    float rs = rsqrtf(ss * (1.f / D) + 1e-6f);
    const float* md = mod + (size_t)k.modi * NMOD;
#pragma unroll
    for (int j = 0; j < 4; ++j) { int c = threadIdx.x * 4 + j; float y = v[j] * rs * g[c] * (1.f + md[sc_off + c]) + md[sh_off + c]; out[(size_t)m * D + c] = (bf16_t)f2bf(y); }
}
__global__ void k_final_norm(float* __restrict__ x, const float* __restrict__ g) {
    __shared__ float sh[4];
    int m = blockIdx.x; float* xr = x + (size_t)m * D;
    f32x4 v = *(const f32x4*)(xr + threadIdx.x * 4);
    float ss = block_sum256(v.x * v.x + v.y * v.y + v.z * v.z + v.w * v.w, sh);
    float rs = rsqrtf(ss * (1.f / D) + 1e-6f);
    f32x4 gv = *(const f32x4*)(g + threadIdx.x * 4);
    f32x4 o;
#pragma unroll
    for (int j = 0; j < 4; ++j) o[j] = v[j] * rs * gv[j];
    *(f32x4*)(xr + threadIdx.x * 4) = o;
}
struct EpiArgs { bf16_t* obf; int ldo; float* of32; const float* xa; const float* xb; const float* mod; int gate_off; int pad; };
template <int EPI>
__global__ void __launch_bounds__(256) k_gemm(const bf16_t* __restrict__ A, const bf16_t* __restrict__ Bt, int K, EpiArgs e) {
    const int lane = threadIdx.x & 63, wid = threadIdx.x >> 6, fr = lane & 15, fq = lane >> 4;
    const int m0 = blockIdx.y * 128 + (wid >> 1) * 64, n0 = blockIdx.x * 128 + (wid & 1) * 64;
    f32x4 acc[4][4];
#pragma unroll
    for (int i = 0; i < 4; ++i)
#pragma unroll
        for (int j = 0; j < 4; ++j) acc[i][j] = (f32x4){0.f, 0.f, 0.f, 0.f};
    const bf16_t* ap = A + (size_t)(m0 + fr) * K + fq * 8;
    const bf16_t* bp = Bt + (size_t)(n0 + fr) * K + fq * 8;
    for (int k0 = 0; k0 < K; k0 += 32) {
        bf16x8 a[4], b[4];
#pragma unroll
        for (int i = 0; i < 4; ++i) { a[i] = *(const bf16x8*)(ap + (size_t)i * 16 * K + k0); b[i] = *(const bf16x8*)(bp + (size_t)i * 16 * K + k0); }
#pragma unroll
        for (int i = 0; i < 4; ++i)
#pragma unroll
            for (int j = 0; j < 4; ++j) acc[i][j] = __builtin_amdgcn_mfma_f32_16x16x32_bf16(a[i], b[j], acc[i][j], 0, 0, 0);
    }
#pragma unroll
    for (int i = 0; i < 4; ++i)
#pragma unroll
        for (int j = 0; j < 4; ++j)
#pragma unroll
            for (int r = 0; r < 4; ++r) {
                const int row = m0 + i * 16 + fq * 4 + r, col = n0 + j * 16 + fr; const float v = acc[i][j][r];
                if (EPI == 0) e.obf[(size_t)row * e.ldo + col] = (bf16_t)f2bf(v);
                else if (EPI == 2) { float t = fmaxf(v, 0.f); e.obf[(size_t)row * e.ldo + col] = (bf16_t)f2bf(t * t); }
                else {
                    const int modi = row < M_P ? 0 : 1 + (row - M_P) / L_S; const float gt = e.mod[(size_t)modi * NMOD + e.gate_off + col];
                    if (EPI == 1) { const float xv = row < M_P ? e.xa[(size_t)row * D + col] : e.xb[(size_t)(row - M_P) * D + col]; e.of32[(size_t)row * D + col] = xv + gt * v; }
                    else e.of32[(size_t)row * D + col] += gt * v;
                }
            }
}
struct PrepArgs {
    const bf16_t* proj; bf16_t* scan; bf16_t* lgf; bf16_t* lgb; bf16_t* gate;
    const float *mu_rkv, *w0, *w2, *a0, *a2, *g2, *k_k, *gk2, *gk_b;
};
__global__ void __launch_bounds__(256) k_prep(PrepArgs p) {
    __shared__ float lw[128], la[128], lg[128], pgk[32];
    const int m = blockIdx.x, tid = threadIdx.x; const Tok k = tok_of(m);
    const Nb nb = shift_nb(k); const float wgt = nb.wgt;
    const bf16_t* row = p.proj + (size_t)m * N1;
    if (tid < 128) {
        lw[tid] = tanhf(bf2f(row[C_PWA + tid]) + wgt * nb_sum(p.proj, nb, C_PWB + tid));
        la[tid] = bf2f(row[C_PAA + tid]) + wgt * nb_sum(p.proj, nb, C_PAB + tid);
        lg[tid] = sigmoidf_(bf2f(row[C_PGA + tid]) + wgt * nb_sum(p.proj, nb, C_PGB + tid));
        if (tid < 32) pgk[tid] = bf2f(row[C_PGK + tid]);
    }
    __syncthreads();
    for (int pass = 0; pass < 2; ++pass) {
        const int c = tid + pass * 256;
        const float x0 = bf2f(row[c]), x1 = bf2f(row[RW + c]), x2 = bf2f(row[2 * RW + c]);
        const float rr = x0 + p.mu_rkv[c] * (wgt * nb_sum(p.proj, nb, c) - x0);
        const float kx = x1 + p.mu_rkv[RW + c] * (wgt * nb_sum(p.proj, nb, RW + c) - x1);
        const float vv = x2 + p.mu_rkv[2 * RW + c] * (wgt * nb_sum(p.proj, nb, 2 * RW + c) - x2);
        float zf = p.w0[c], zb = p.w0[RW + c], af = p.a0[c], ab = p.a0[RW + c], gt = 0.f;
        for (int r = 0; r < 64; ++r) {
            zf += lw[r] * p.w2[(size_t)r * RW + c]; zb += lw[64 + r] * p.w2[(size_t)(64 + r) * RW + c];
            af += la[r] * p.a2[(size_t)r * RW + c]; ab += la[64 + r] * p.a2[(size_t)(64 + r) * RW + c];
        }
        for (int r = 0; r < 128; ++r) gt += lg[r] * p.g2[(size_t)r * RW + c];
        const float wf = __expf(-0.6065306597126334f * sigmoidf_(zf)), wb = __expf(-0.6065306597126334f * sigmoidf_(zb));
        af = sigmoidf_(af); ab = sigmoidf_(ab);
        float kk = kx * p.k_k[c]; float s2 = kk * kk;
        for (int o = 1; o < 64; o <<= 1) s2 += __shfl_xor(s2, o);
        kk *= rsqrtf(fmaxf(s2, 1e-12f));
        const size_t o = (size_t)m * RW + c;
        p.scan[0 * SCAN_STRIDE + o] = (bf16_t)f2bf(rr); p.scan[1 * SCAN_STRIDE + o] = (bf16_t)f2bf(kx); p.scan[2 * SCAN_STRIDE + o] = (bf16_t)f2bf(vv);
        p.scan[3 * SCAN_STRIDE + o] = (bf16_t)f2bf(kk);
        p.scan[4 * SCAN_STRIDE + o] = (bf16_t)f2bf(wf); p.scan[5 * SCAN_STRIDE + o] = (bf16_t)f2bf(wb);
        p.scan[6 * SCAN_STRIDE + o] = (bf16_t)f2bf(af); p.scan[7 * SCAN_STRIDE + o] = (bf16_t)f2bf(ab);
        p.gate[o] = (bf16_t)f2bf(gt);
    }
    {   const int c = tid;
        float l0 = p.gk_b[c], l1 = p.gk_b[GQK + c];
        for (int r = 0; r < 16; ++r) { l0 += pgk[r] * p.gk2[(size_t)r * GQK + c]; l1 += pgk[16 + r] * p.gk2[(size_t)(16 + r) * GQK + c]; }
        p.lgf[(size_t)m * GQK + c] = (bf16_t)f2bf(log_sigmoidf_(l0) * (1.f / 16.f)); p.lgb[(size_t)m * GQK + c] = (bf16_t)f2bf(log_sigmoidf_(l1) * (1.f / 16.f));
    }
}
struct RwkvArgs { bf16_t* scan; const float* k_a; const float* s_f; const float* s_b; float* os_f; float* os_b; };
__global__ void __launch_bounds__(64) k_rwkv(RwkvArgs p) {
    constexpr int CH = 16;
    __shared__ float sr[CH][64], sw[CH][64], sk[CH][64], sv[CH][64], skk[CH][64], sb[CH][64];
    const int u = blockIdx.x, dir = u & 1, h = (u >> 1) & 7, bb = u >> 4, i = threadIdx.x;
    const bool sample = bb >= NB_P; const int b = sample ? bb - NB_P : bb, L = sample ? L_S : L_P, base = sample ? M_P + b * L_S : b * L_P;
    float s[64];
    if (sample) { const float* s0 = (dir ? p.s_b : p.s_f) + ((size_t)(b * NH + h) * 64 + i) * 64;
#pragma unroll
        for (int j = 0; j < 64; ++j) s[j] = s0[j]; }
    else {
#pragma unroll
        for (int j = 0; j < 64; ++j) s[j] = 0.f; }
    const float ka = p.k_a[h * 64 + i];
    bf16_t* W = p.scan + (size_t)(4 + dir) * SCAN_STRIDE; const bf16_t* A = p.scan + (size_t)(6 + dir) * SCAN_STRIDE;
    for (int c0 = 0; c0 < L; c0 += CH) {
        __syncthreads();
        for (int q = 0; q < CH; ++q) {
            const int t = dir ? L - 1 - (c0 + q) : c0 + q; const size_t o = (size_t)(base + t) * RW + h * 64 + i;
            const float r = bf2f(p.scan[o]), k = bf2f(p.scan[SCAN_STRIDE + o]), v = bf2f(p.scan[2 * SCAN_STRIDE + o]), kk = bf2f(p.scan[3 * SCAN_STRIDE + o]);
            const float w = bf2f(W[o]), a = bf2f(A[o]);
            sr[q][i] = r; sw[q][i] = w; sk[q][i] = k * (1.f + (a - 1.f) * ka); sv[q][i] = v; skk[q][i] = kk; sb[q][i] = kk * a;
        }
        __syncthreads();
        for (int q = 0; q < CH; ++q) {
            float sa = 0.f;
#pragma unroll
            for (int j = 0; j < 64; ++j) sa -= s[j] * skk[q][j];
            const float v = sv[q][i]; float y = 0.f;
#pragma unroll
            for (int j = 0; j < 64; ++j) { s[j] = s[j] * sw[q][j] + sa * sb[q][j] + v * sk[q][j]; y += s[j] * sr[q][j]; }
            const int t = dir ? L - 1 - (c0 + q) : c0 + q;
            W[(size_t)(base + t) * RW + h * 64 + i] = (bf16_t)f2bf(y);
        }
    }
    if (!sample) { float* os = (dir ? p.os_b : p.os_f) + ((size_t)(b * NH + h) * 64 + i) * 64;
#pragma unroll
        for (int j = 0; j < 64; ++j) os[j] = s[j]; }
}
struct GlaArgs { const bf16_t* proj; const bf16_t* lgf; const bf16_t* lgb; bf16_t* of; bf16_t* ob; const float* s_f; const float* s_b; float* os_f; float* os_b; };
__global__ void __launch_bounds__(128) k_gla(GlaArgs p) {
    constexpr int CH = 16;
    __shared__ float sq[CH][64], sk[CH][64], sa[CH][64];
    const int u = blockIdx.x, dir = u & 1, h = (u >> 1) & 3, bb = u >> 3, vcol = threadIdx.x;
    const bool sample = bb >= NB_P; const int b = sample ? bb - NB_P : bb, L = sample ? L_S : L_P, base = sample ? M_P + b * L_S : b * L_P;
    float s[64];
    if (sample) { const float* s0 = (dir ? p.s_b : p.s_f) + (size_t)(b * GH + h) * 64 * 128 + vcol;
#pragma unroll
        for (int j = 0; j < 64; ++j) s[j] = s0[(size_t)j * 128]; }
    else {
#pragma unroll
        for (int j = 0; j < 64; ++j) s[j] = 0.f; }
    const bf16_t* LG = dir ? p.lgb : p.lgf; bf16_t* O = dir ? p.ob : p.of;
    for (int c0 = 0; c0 < L; c0 += CH) {
        __syncthreads();
        for (int e = threadIdx.x; e < CH * 64; e += 128) { const int q = e >> 6, j = e & 63; const int t = dir ? L - 1 - (c0 + q) : c0 + q; const size_t m = base + t;
            sq[q][j] = bf2f(p.proj[m * N1 + C_GQ + h * 64 + j]) * 0.125f; sk[q][j] = bf2f(p.proj[m * N1 + C_GK + h * 64 + j]); sa[q][j] = __expf(bf2f(LG[m * GQK + h * 64 + j])); }
        __syncthreads();
        for (int q = 0; q < CH; ++q) {
            const int t = dir ? L - 1 - (c0 + q) : c0 + q; const size_t m = base + t;
            const float v = bf2f(p.proj[m * N1 + C_GV + h * 128 + vcol]); float o = 0.f;
#pragma unroll
            for (int j = 0; j < 64; ++j) { s[j] = s[j] * sa[q][j] + sk[q][j] * v; o += sq[q][j] * s[j]; }
            O[m * RW + h * 128 + vcol] = (bf16_t)f2bf(o);
        }
    }
    if (!sample) { float* os = (dir ? p.os_b : p.os_f) + (size_t)(b * GH + h) * 64 * 128 + vcol;
#pragma unroll
        for (int j = 0; j < 64; ++j) os[(size_t)j * 128] = s[j]; }
}
struct CombArgs { const bf16_t* scan; const bf16_t* gate; const bf16_t* of; const bf16_t* ob; const bf16_t* proj; bf16_t* mix;
                  const float *k_a, *r_k, *lnx_g, *lnx_b, *gla_g; };
__global__ void __launch_bounds__(256) k_combine(CombArgs p) {
    __shared__ float part[4];
    const int m = blockIdx.x, tid = threadIdx.x;
    for (int pass = 0; pass < 2; ++pass) {
        const int c = tid + pass * 256; const size_t o = (size_t)m * RW + c;
        const float y = bf2f(p.scan[4 * SCAN_STRIDE + o]) + bf2f(p.scan[5 * SCAN_STRIDE + o]);
        float s1 = y; for (int q = 1; q < 64; q <<= 1) s1 += __shfl_xor(s1, q);
        const float mu = s1 * (1.f / 64.f); const float d = y - mu;
        float s2 = d * d; for (int q = 1; q < 64; q <<= 1) s2 += __shfl_xor(s2, q);
        const float yn = d * rsqrtf(s2 * (1.f / 64.f) + 64e-5f) * p.lnx_g[c] + p.lnx_b[c];
        const float r = bf2f(p.scan[o]), k = bf2f(p.scan[SCAN_STRIDE + o]), v = bf2f(p.scan[2 * SCAN_STRIDE + o]);
        const float af = bf2f(p.scan[6 * SCAN_STRIDE + o]), ab = bf2f(p.scan[7 * SCAN_STRIDE + o]), ka = p.k_a[c];
        const float kds = k * (1.f + (af - 1.f) * ka) + k * (1.f + (ab - 1.f) * ka);
        float s3 = r * kds * p.r_k[c]; for (int q = 1; q < 64; q <<= 1) s3 += __shfl_xor(s3, q);
        const float outv = (yn + s3 * v) * bf2f(p.gate[o]);
        p.mix[(size_t)m * D + c] = (bf16_t)f2bf(outv);
    }
    for (int pass = 0; pass < 2; ++pass) {
        const int c = tid + pass * 256; const size_t o = (size_t)m * RW + c;
        const float ov = bf2f(p.of[o]) + bf2f(p.ob[o]);
        float s2 = ov * ov; for (int q = 1; q < 64; q <<= 1) s2 += __shfl_xor(s2, q);
        __syncthreads();
        if ((tid & 63) == 0) part[tid >> 6] = s2;
        __syncthreads();
        const float tot = part[(tid >> 7) * 2] + part[(tid >> 7) * 2 + 1];
        const float gg = bf2f(p.proj[(size_t)m * N1 + C_GG + c]);
        const float outv = ov * rsqrtf(tot * (1.f / 128.f) + 1e-5f) * p.gla_g[c & 127] * (gg * sigmoidf_(gg));
        p.mix[(size_t)m * D + RW + c] = (bf16_t)f2bf(outv);
    }
}

extern "C" void kernel_launch(void* const* d_in, const int* in_sizes, int n_in, void* d_out, int out_size, void* d_ws, size_t ws_size, hipStream_t stream) {
    const float* x_prompt = (const float*)d_in[0]; const float* x_sample = (const float*)d_in[1]; const float* cc = (const float*)d_in[2];
    const float* srf = (const float*)d_in[3]; const float* srb = (const float*)d_in[4]; const float* sgf = (const float*)d_in[5]; const float* sgb = (const float*)d_in[6];
    const float* c_ctx = (const float*)d_in[7]; const float* ada_w = (const float*)d_in[8]; const float* ada_b = (const float*)d_in[9];
    const float* norm1_g = (const float*)d_in[10]; const float* norm2_g = (const float*)d_in[11]; const float* w_in = (const float*)d_in[12];
    const float* mu_rkv = (const float*)d_in[13]; const float* mu_wag = (const float*)d_in[14]; const float* w0 = (const float*)d_in[15];
    const float* w1 = (const float*)d_in[16]; const float* w2 = (const float*)d_in[17]; const float* a0 = (const float*)d_in[18];
    const float* a1 = (const float*)d_in[19]; const float* a2 = (const float*)d_in[20]; const float* g1 = (const float*)d_in[21]; const float* g2 = (const float*)d_in[22];
    const float* k_k = (const float*)d_in[23]; const float* k_a = (const float*)d_in[24]; const float* r_k = (const float*)d_in[25];
    const float* lnx_g = (const float*)d_in[26]; const float* lnx_b = (const float*)d_in[27]; const float* gk1 = (const float*)d_in[28];
    const float* gk2 = (const float*)d_in[29]; const float* gk_b = (const float*)d_in[30]; const float* gla_g = (const float*)d_in[31];
    const float* w_out = (const float*)d_in[32]; const float* mlp_w1 = (const float*)d_in[33]; const float* mlp_w2 = (const float*)d_in[34]; const float* final_g = (const float*)d_in[35];
    unsigned char* ws = (unsigned char*)d_ws; unsigned char* dout = (unsigned char*)d_out; float* outf = (float*)d_out;
    bf16_t* WC1T = (bf16_t*)(ws + WS_WC1T); bf16_t* WOT = (bf16_t*)(ws + WS_WOT); bf16_t* W1T = (bf16_t*)(ws + WS_W1T); bf16_t* W2T = (bf16_t*)(ws + WS_W2T);
    float* MOD = (float*)(ws + WS_MOD); bf16_t* XN = (bf16_t*)(ws + WS_XN); bf16_t* MIX = XN; bf16_t* PROJ = (bf16_t*)(ws + WS_PROJ); bf16_t* HB = PROJ;
    bf16_t* SCAN = (bf16_t*)(ws + WS_SCAN); bf16_t* XN2 = SCAN;
    bf16_t* LGF = (bf16_t*)(dout + DO_LGF); bf16_t* LGB = (bf16_t*)(dout + DO_LGB); bf16_t* OF = (bf16_t*)(dout + DO_OF); bf16_t* OB = (bf16_t*)(dout + DO_OB); bf16_t* GATE = (bf16_t*)(dout + DO_GATE);
    float* OS_RF = outf + (size_t)M * D; float* OS_RB = OS_RF + 524288; float* OS_GF = OS_RB + 524288; float* OS_GB = OS_GF + 524288;

    k_transpose<<<(D * 3072 + 255) / 256, 256, 0, stream>>>(w_in, D, 3072, WC1T);
    k_fold<<<((N1 - LA) * D + 255) / 256, 256, 0, stream>>>(mu_wag, w1, a1, g1, gk1, WC1T);
    k_transpose<<<(D * D + 255) / 256, 256, 0, stream>>>(w_out, D, D, WOT);
    k_transpose<<<(D * FF + 255) / 256, 256, 0, stream>>>(mlp_w1, D, FF, W1T);
    k_transpose<<<(D * FF + 255) / 256, 256, 0, stream>>>(mlp_w2, FF, D, W2T);
    k_mod<<<(5 * NMOD + 255) / 256, 256, 0, stream>>>(cc, c_ctx, ada_w, ada_b, MOD);
    k_norm_mod<<<M, 256, 0, stream>>>(x_prompt, x_sample, norm1_g, MOD, 0, D, XN);
    { EpiArgs e{}; e.obf = PROJ; e.ldo = N1; k_gemm<0><<<dim3(N1 / 128, M / 128), 256, 0, stream>>>(XN, WC1T, D, e); }
    { PrepArgs p{}; p.proj = PROJ; p.scan = SCAN; p.lgf = LGF; p.lgb = LGB; p.gate = GATE; p.mu_rkv = mu_rkv; p.w0 = w0; p.w2 = w2; p.a0 = a0; p.a2 = a2; p.g2 = g2; p.k_k = k_k; p.gk2 = gk2; p.gk_b = gk_b;
      k_prep<<<M, 256, 0, stream>>>(p); }
    { RwkvArgs p{}; p.scan = SCAN; p.k_a = k_a; p.s_f = srf; p.s_b = srb; p.os_f = OS_RF; p.os_b = OS_RB; k_rwkv<<<(NB_P + NB_S) * NH * 2, 64, 0, stream>>>(p); }
    { GlaArgs p{}; p.proj = PROJ; p.lgf = LGF; p.lgb = LGB; p.of = OF; p.ob = OB; p.s_f = sgf; p.s_b = sgb; p.os_f = OS_GF; p.os_b = OS_GB; k_gla<<<(NB_P + NB_S) * GH * 2, 128, 0, stream>>>(p); }
    { CombArgs p{}; p.scan = SCAN; p.gate = GATE; p.of = OF; p.ob = OB; p.proj = PROJ; p.mix = MIX; p.k_a = k_a; p.r_k = r_k; p.lnx_g = lnx_g; p.lnx_b = lnx_b; p.gla_g = gla_g;
      k_combine<<<M, 256, 0, stream>>>(p); }
    { EpiArgs e{}; e.of32 = outf; e.xa = x_prompt; e.xb = x_sample; e.mod = MOD; e.gate_off = 2 * D; k_gemm<1><<<dim3(D / 128, M / 128), 256, 0, stream>>>(MIX, WOT, D, e); }
    k_norm_mod<<<M, 256, 0, stream>>>(outf, nullptr, norm2_g, MOD, 3 * D, 4 * D, XN2);
    { EpiArgs e{}; e.obf = HB; e.ldo = FF; k_gemm<2><<<dim3(FF / 128, M / 128), 256, 0, stream>>>(XN2, W1T, D, e); }
    { EpiArgs e{}; e.of32 = outf; e.mod = MOD; e.gate_off = 5 * D; k_gemm<3><<<dim3(D / 128, M / 128), 256, 0, stream>>>(HB, W2T, FF, e); }
    k_final_norm<<<M, 256, 0, stream>>>(outf, final_g);
}
```

```cpp
#include <hip/hip_runtime.h>
#include <stdint.h>

typedef unsigned short bf16_t;
typedef short bf16x8 __attribute__((ext_vector_type(8)));
typedef float f32x4 __attribute__((ext_vector_type(4)));

constexpr int D = 1024, NB_P = 16, L_P = 256, NB_S = 4, L_S = 2048;
constexpr int M_P = NB_P * L_P, M_S = NB_S * L_S, M = M_P + M_S;
constexpr int RW = 512, NH = 8, HD = 64, GH = 4, GKD = 64, GVD = 128, GQK = 256;
constexpr int FF = 4096, N1 = 4096, LA = 3072, NMOD = 6 * D;
constexpr int GRID_W = 64;
constexpr int C_GQ = 1536, C_GK = 1792, C_GV = 2048, C_GG = 2560;
constexpr int C_PWA = LA, C_PAA = LA + 128, C_PGA = LA + 256, C_PWB = LA + 384, C_PAB = LA + 512, C_PGB = LA + 640, C_PGK = LA + 768;

constexpr size_t MiB = 1u << 20;
constexpr size_t WS_WC1T = 1 * MiB, WS_WOT = 9 * MiB, WS_W1T = 11 * MiB, WS_W2T = 19 * MiB;
constexpr size_t WS_MOD = 27 * MiB;
constexpr size_t WS_XN = 29 * MiB;
constexpr size_t WS_PROJ = 53 * MiB;
constexpr size_t WS_SCAN = 149 * MiB;
constexpr size_t SCAN_STRIDE = (size_t)M * RW;
constexpr size_t DO_LGF = 0, DO_LGB = 6 * MiB, DO_OF = 12 * MiB, DO_OB = 24 * MiB, DO_GATE = 36 * MiB;

__device__ __forceinline__ unsigned f2bf(float f) { unsigned u = __builtin_bit_cast(unsigned, f); return (u + 0x7fffu + ((u >> 16) & 1u)) >> 16; }
__device__ __forceinline__ float bf2f(bf16_t h) { return __builtin_bit_cast(float, (unsigned)h << 16); }
__device__ __forceinline__ float sigmoidf_(float x) { return 1.f / (1.f + __expf(-x)); }
__device__ __forceinline__ float log_sigmoidf_(float x) { return fminf(x, 0.f) - log1pf(__expf(-fabsf(x))); }

struct Tok { int b, t, L, base, modi; bool sample; };
__device__ __forceinline__ Tok tok_of(int m) {
    Tok k;
    if (m < M_P) { k.b = m / L_P; k.t = m % L_P; k.L = L_P; k.base = k.b * L_P; k.modi = 0; k.sample = false; }
    else { int q = m - M_P; k.b = q / L_S; k.t = q % L_S; k.L = L_S; k.base = M_P + k.b * L_S; k.modi = 1 + k.b; k.sample = true; }
    return k;
}
struct Nb { int n0, n1, n2, n3; float wgt; };
__device__ __forceinline__ Nb shift_nb(const Tok& k) {
    Nb r; r.n0 = r.n1 = r.n2 = r.n3 = -1;
    if (!k.sample) { r.wgt = 0.5f; if (k.t > 0) r.n0 = k.base + k.t - 1; if (k.t < k.L - 1) r.n1 = k.base + k.t + 1; }
    else { r.wgt = 0.25f; const int row = k.t / GRID_W, col = k.t % GRID_W;
        if (row > 0) r.n0 = k.base + k.t - GRID_W; if (row < L_S / GRID_W - 1) r.n1 = k.base + k.t + GRID_W;
        if (col > 0) r.n2 = k.base + k.t - 1; if (col < GRID_W - 1) r.n3 = k.base + k.t + 1; }
    return r;
}
__device__ __forceinline__ float nb_sum(const bf16_t* proj, const Nb& nb, int col) {
    float s = 0.f;
    if (nb.n0 >= 0) s += bf2f(proj[(size_t)nb.n0 * N1 + col]);
    if (nb.n1 >= 0) s += bf2f(proj[(size_t)nb.n1 * N1 + col]);
    if (nb.n2 >= 0) s += bf2f(proj[(size_t)nb.n2 * N1 + col]);
    if (nb.n3 >= 0) s += bf2f(proj[(size_t)nb.n3 * N1 + col]);
    return s;
}

#include <cstdio>
struct PrepArgs {
    const bf16_t* proj; bf16_t* scan; bf16_t* lgf; bf16_t* lgb; bf16_t* gate;
    const float *mu_rkv, *w0, *w2, *a0, *a2, *g2, *k_k, *gk2, *gk_b;
};
__global__ void __launch_bounds__(256) k_prep(PrepArgs p) {
    __shared__ float lw[128], la[128], lg[128], pgk[32];
    const int m = blockIdx.x, tid = threadIdx.x; const Tok k = tok_of(m);
    const Nb nb = shift_nb(k); const float wgt = nb.wgt;
    const bf16_t* row = p.proj + (size_t)m * N1;
    if (tid < 128) {
        lw[tid] = tanhf(bf2f(row[C_PWA + tid]) + wgt * nb_sum(p.proj, nb, C_PWB + tid));
        la[tid] = bf2f(row[C_PAA + tid]) + wgt * nb_sum(p.proj, nb, C_PAB + tid);
        lg[tid] = sigmoidf_(bf2f(row[C_PGA + tid]) + wgt * nb_sum(p.proj, nb, C_PGB + tid));
        if (tid < 32) pgk[tid] = bf2f(row[C_PGK + tid]);
    }
    __syncthreads();
    for (int pass = 0; pass < 2; ++pass) {
        const int c = tid + pass * 256;
        const float x0 = bf2f(row[c]), x1 = bf2f(row[RW + c]), x2 = bf2f(row[2 * RW + c]);
        const float rr = x0 + p.mu_rkv[c] * (wgt * nb_sum(p.proj, nb, c) - x0);
        const float kx = x1 + p.mu_rkv[RW + c] * (wgt * nb_sum(p.proj, nb, RW + c) - x1);
        const float vv = x2 + p.mu_rkv[2 * RW + c] * (wgt * nb_sum(p.proj, nb, 2 * RW + c) - x2);
        float zf = p.w0[c], zb = p.w0[RW + c], af = p.a0[c], ab = p.a0[RW + c], gt = 0.f;
        for (int r = 0; r < 64; ++r) {
            zf += lw[r] * p.w2[(size_t)r * RW + c]; zb += lw[64 + r] * p.w2[(size_t)(64 + r) * RW + c];
            af += la[r] * p.a2[(size_t)r * RW + c]; ab += la[64 + r] * p.a2[(size_t)(64 + r) * RW + c];
        }
        for (int r = 0; r < 128; ++r) gt += lg[r] * p.g2[(size_t)r * RW + c];
        const float wf = __expf(-0.6065306597126334f * sigmoidf_(zf)), wb = __expf(-0.6065306597126334f * sigmoidf_(zb));
        af = sigmoidf_(af); ab = sigmoidf_(ab);
        float kk = kx * p.k_k[c]; float s2 = kk * kk;
        for (int o = 1; o < 64; o <<= 1) s2 += __shfl_xor(s2, o);
        kk *= rsqrtf(fmaxf(s2, 1e-12f));
        const size_t o = (size_t)m * RW + c;
        p.scan[0 * SCAN_STRIDE + o] = (bf16_t)f2bf(rr); p.scan[1 * SCAN_STRIDE + o] = (bf16_t)f2bf(kx); p.scan[2 * SCAN_STRIDE + o] = (bf16_t)f2bf(vv);
        p.scan[3 * SCAN_STRIDE + o] = (bf16_t)f2bf(kk);
        p.scan[4 * SCAN_STRIDE + o] = (bf16_t)f2bf(wf); p.scan[5 * SCAN_STRIDE + o] = (bf16_t)f2bf(wb);
        p.scan[6 * SCAN_STRIDE + o] = (bf16_t)f2bf(af); p.scan[7 * SCAN_STRIDE + o] = (bf16_t)f2bf(ab);
        p.gate[o] = (bf16_t)f2bf(gt);
    }
    {   const int c = tid;
        float l0 = p.gk_b[c], l1 = p.gk_b[GQK + c];
        for (int r = 0; r < 16; ++r) { l0 += pgk[r] * p.gk2[(size_t)r * GQK + c]; l1 += pgk[16 + r] * p.gk2[(size_t)(16 + r) * GQK + c]; }
        p.lgf[(size_t)m * GQK + c] = (bf16_t)f2bf(log_sigmoidf_(l0) * (1.f / 16.f)); p.lgb[(size_t)m * GQK + c] = (bf16_t)f2bf(log_sigmoidf_(l1) * (1.f / 16.f));
    }
}
struct RwkvArgs { bf16_t* scan; const float* k_a; const float* s_f; const float* s_b; float* os_f; float* os_b; };
__global__ void __launch_bounds__(64) k_rwkv(RwkvArgs p) {
    constexpr int CH = 16;
    __shared__ float sr[CH][64], sw[CH][64], sk[CH][64], sv[CH][64], skk[CH][64], sb[CH][64];
    const int u = blockIdx.x, dir = u & 1, h = (u >> 1) & 7, bb = u >> 4, i = threadIdx.x;
    const bool sample = bb >= NB_P; const int b = sample ? bb - NB_P : bb, L = sample ? L_S : L_P, base = sample ? M_P + b * L_S : b * L_P;
    float s[64];
    if (sample) { const float* s0 = (dir ? p.s_b : p.s_f) + ((size_t)(b * NH + h) * 64 + i) * 64;
#pragma unroll
        for (int j = 0; j < 64; ++j) s[j] = s0[j]; }
    else {
#pragma unroll
        for (int j = 0; j < 64; ++j) s[j] = 0.f; }
    const float ka = p.k_a[h * 64 + i];
    bf16_t* W = p.scan + (size_t)(4 + dir) * SCAN_STRIDE; const bf16_t* A = p.scan + (size_t)(6 + dir) * SCAN_STRIDE;
    for (int c0 = 0; c0 < L; c0 += CH) {
        __syncthreads();
        for (int q = 0; q < CH; ++q) {
            const int t = dir ? L - 1 - (c0 + q) : c0 + q; const size_t o = (size_t)(base + t) * RW + h * 64 + i;
            const float r = bf2f(p.scan[o]), k = bf2f(p.scan[SCAN_STRIDE + o]), v = bf2f(p.scan[2 * SCAN_STRIDE + o]), kk = bf2f(p.scan[3 * SCAN_STRIDE + o]);
            const float w = bf2f(W[o]), a = bf2f(A[o]);
            sr[q][i] = r; sw[q][i] = w; sk[q][i] = k * (1.f + (a - 1.f) * ka); sv[q][i] = v; skk[q][i] = kk; sb[q][i] = kk * a;
        }
        __syncthreads();
        for (int q = 0; q < CH; ++q) {
            float sa = 0.f;
#pragma unroll
            for (int j = 0; j < 64; ++j) sa -= s[j] * skk[q][j];
            const float v = sv[q][i]; float y = 0.f;
#pragma unroll
            for (int j = 0; j < 64; ++j) { s[j] = s[j] * sw[q][j] + sa * sb[q][j] + v * sk[q][j]; y += s[j] * sr[q][j]; }
            const int t = dir ? L - 1 - (c0 + q) : c0 + q;
            W[(size_t)(base + t) * RW + h * 64 + i] = (bf16_t)f2bf(y);
        }
    }
    if (!sample) { float* os = (dir ? p.os_b : p.os_f) + ((size_t)(b * NH + h) * 64 + i) * 64;
#pragma unroll
        for (int j = 0; j < 64; ++j) os[j] = s[j]; }
}
struct GlaArgs { const bf16_t* proj; const bf16_t* lgf; const bf16_t* lgb; bf16_t* of; bf16_t* ob; const float* s_f; const float* s_b; float* os_f; float* os_b; };
__global__ void __launch_bounds__(128) k_gla(GlaArgs p) {
    constexpr int CH = 16;
    __shared__ float sq[CH][64], sk[CH][64], sa[CH][64];
    const int u = blockIdx.x, dir = u & 1, h = (u >> 1) & 3, bb = u >> 3, vcol = threadIdx.x;
    const bool sample = bb >= NB_P; const int b = sample ? bb - NB_P : bb, L = sample ? L_S : L_P, base = sample ? M_P + b * L_S : b * L_P;
    float s[64];
    if (sample) { const float* s0 = (dir ? p.s_b : p.s_f) + (size_t)(b * GH + h) * 64 * 128 + vcol;
#pragma unroll
        for (int j = 0; j < 64; ++j) s[j] = s0[(size_t)j * 128]; }
    else {
#pragma unroll
        for (int j = 0; j < 64; ++j) s[j] = 0.f; }
    const bf16_t* LG = dir ? p.lgb : p.lgf; bf16_t* O = dir ? p.ob : p.of;
    for (int c0 = 0; c0 < L; c0 += CH) {
        __syncthreads();
        for (int e = threadIdx.x; e < CH * 64; e += 128) { const int q = e >> 6, j = e & 63; const int t = dir ? L - 1 - (c0 + q) : c0 + q; const size_t m = base + t;
            sq[q][j] = bf2f(p.proj[m * N1 + C_GQ + h * 64 + j]) * 0.125f; sk[q][j] = bf2f(p.proj[m * N1 + C_GK + h * 64 + j]); sa[q][j] = __expf(bf2f(LG[m * GQK + h * 64 + j])); }
        __syncthreads();
        for (int q = 0; q < CH; ++q) {
            const int t = dir ? L - 1 - (c0 + q) : c0 + q; const size_t m = base + t;
            const float v = bf2f(p.proj[m * N1 + C_GV + h * 128 + vcol]); float o = 0.f;
#pragma unroll
            for (int j = 0; j < 64; ++j) { s[j] = s[j] * sa[q][j] + sk[q][j] * v; o += sq[q][j] * s[j]; }
            O[m * RW + h * 128 + vcol] = (bf16_t)f2bf(o);
        }
    }
    if (!sample) { float* os = (dir ? p.os_b : p.os_f) + (size_t)(b * GH + h) * 64 * 128 + vcol;
#pragma unroll
        for (int j = 0; j < 64; ++j) os[(size_t)j * 128] = s[j]; }
}
struct CombArgs { const bf16_t* scan; const bf16_t* gate; const bf16_t* of; const bf16_t* ob; const bf16_t* proj; bf16_t* mix;
                  const float *k_a, *r_k, *lnx_g, *lnx_b, *gla_g; };
__global__ void __launch_bounds__(256) k_combine(CombArgs p) {
    __shared__ float part[4];
    const int m = blockIdx.x, tid = threadIdx.x;
    for (int pass = 0; pass < 2; ++pass) {
        const int c = tid + pass * 256; const size_t o = (size_t)m * RW + c;
        const float y = bf2f(p.scan[4 * SCAN_STRIDE + o]) + bf2f(p.scan[5 * SCAN_STRIDE + o]);
        float s1 = y; for (int q = 1; q < 64; q <<= 1) s1 += __shfl_xor(s1, q);
        const float mu = s1 * (1.f / 64.f); const float d = y - mu;
        float s2 = d * d; for (int q = 1; q < 64; q <<= 1) s2 += __shfl_xor(s2, q);
        const float yn = d * rsqrtf(s2 * (1.f / 64.f) + 64e-5f) * p.lnx_g[c] + p.lnx_b[c];
        const float r = bf2f(p.scan[o]), k = bf2f(p.scan[SCAN_STRIDE + o]), v = bf2f(p.scan[2 * SCAN_STRIDE + o]);
        const float af = bf2f(p.scan[6 * SCAN_STRIDE + o]), ab = bf2f(p.scan[7 * SCAN_STRIDE + o]), ka = p.k_a[c];
        const float kds = k * (1.f + (af - 1.f) * ka) + k * (1.f + (ab - 1.f) * ka);
        float s3 = r * kds * p.r_k[c]; for (int q = 1; q < 64; q <<= 1) s3 += __shfl_xor(s3, q);
        const float outv = (yn + s3 * v) * bf2f(p.gate[o]);
        p.mix[(size_t)m * D + c] = (bf16_t)f2bf(outv);
    }
    for (int pass = 0; pass < 2; ++pass) {
        const int c = tid + pass * 256; const size_t o = (size_t)m * RW + c;
        const float ov = bf2f(p.of[o]) + bf2f(p.ob[o]);
        float s2 = ov * ov; for (int q = 1; q < 64; q <<= 1) s2 += __shfl_xor(s2, q);
        __syncthreads();
        if ((tid & 63) == 0) part[tid >> 6] = s2;
        __syncthreads();
        const float tot = part[(tid >> 7) * 2] + part[(tid >> 7) * 2 + 1];
        const float gg = bf2f(p.proj[(size_t)m * N1 + C_GG + c]);
        const float outv = ov * rsqrtf(tot * (1.f / 128.f) + 1e-5f) * p.gla_g[c & 127] * (gg * sigmoidf_(gg));
        p.mix[(size_t)m * D + RW + c] = (bf16_t)f2bf(outv);
    }
}

#define LAS __attribute__((address_space(3)))
namespace pg8 {
#define PG8_LAS __attribute__((address_space(3)))
typedef unsigned short bf16_t;
typedef short bf16x8 __attribute__((ext_vector_type(8)));
typedef float f32x4 __attribute__((ext_vector_type(4)));
typedef unsigned u32x4 __attribute__((ext_vector_type(4)));
constexpr int BM = 256, BK = 64, HALF = 128, HTB = HALF * BK * 2  , STAGE_BYTES = 8 * HTB, NXCD = 8, WGM = 8;

__host__ __device__ __forceinline__ int lds_byte(int r, int c) { const int st = (r >> 4) * 2 + (c >> 5), rr = r & 15, cc = c & 31, ob = rr * 64 + cc * 2; return st * 1024 + (ob ^ (((ob >> 9) & 1) << 5)); }
__host__ __device__ __forceinline__ void stage_rc(int b, int& R, int& C) { const int st = b / 1024, sb = b % 1024, swz = sb ^ (((sb >> 9) & 1) << 5); R = (st >> 1) * 16 + swz / 64; C = (st & 1) * 32 + (swz % 64) / 2; }
__host__ __device__ __forceinline__ int perm32(int rho) { const int n = rho >> 4, i = rho & 15; return 8 * (i >> 2) + 4 * n + (i & 3); }

struct Unit { int pm, pn; };
struct Gemm { const bf16_t* A; const bf16_t* Bt; int M, N, K; };

struct StaticOrder {
    int nM, nN, nwg, G, c;
    __host__ __device__ void init(int M, int N, int G_, int c_) { nM = M / BM; nN = N / BM; nwg = nM * nN; G = G_; c = c_; }
    __host__ __device__ bool next(int i, Unit& u) const {
        const long L = (long)i * G + c; if (L >= nwg) return false;
        int wgid = (int)L; { const int q = nwg / NXCD, r = nwg % NXCD, xcd = wgid % NXCD, off = wgid / NXCD; wgid = (xcd < r ? xcd * (q + 1) : r * (q + 1) + (xcd - r) * q) + off; }
        const int nig = WGM * nN, gid = wgid / nig, fm = gid * WGM, gsz = (nM - fm) < WGM ? (nM - fm) : WGM;
        u.pm = fm + ((wgid % nig) % gsz); u.pn = (wgid % nig) / gsz; return true;
    }
    __device__ __forceinline__ void a_ready(const Unit&) const {}
    __device__ __forceinline__ void done(const Unit&) const {}
};

__device__ __forceinline__ unsigned cvt_pk_bf16(float lo, float hi) { unsigned r; asm volatile("v_cvt_pk_bf16_f32 %0, %1, %2" : "=v"(r) : "v"(lo), "v"(hi)); return r; }
typedef float f32x2 __attribute__((ext_vector_type(2)));
template <int ACT  > struct EpiBf16 {
    static constexpr bool PERM = true, AFTER_DRAIN = false;
    bf16_t* O; int ldc;
    __device__ __forceinline__ void operator()(const f32x4 (&acc)[2][2][4][2], const Unit& u, int wr, int wc, int fr, int fq) const {
        const int row0 = u.pm * BM + wr * 64 + fr; const int col0 = u.pn * BM + wc * 32 + 8 * fq;
#pragma unroll
        for (int ai = 0; ai < 2; ++ai)
#pragma unroll
            for (int m = 0; m < 4; ++m) { bf16_t* rowp = O + (size_t)(row0 + ai * HALF + m * 16) * ldc + col0;
#pragma unroll
                for (int bj = 0; bj < 2; ++bj) { f32x4 v0 = acc[ai][bj][m][0], v1 = acc[ai][bj][m][1];
                    if (ACT == 2) {
#pragma unroll
                        for (int q = 0; q < 4; ++q) { const float a = fmaxf(v0[q], 0.f), b = fmaxf(v1[q], 0.f); v0[q] = a * a; v1[q] = b * b; } }
                    u32x4 w; w.x = cvt_pk_bf16(v0[0], v0[1]); w.y = cvt_pk_bf16(v0[2], v0[3]); w.z = cvt_pk_bf16(v1[0], v1[1]); w.w = cvt_pk_bf16(v1[2], v1[3]);
                    *(u32x4*)(rowp + bj * HALF) = w; } }
    }
};
struct EpiGateRes {
    static constexpr bool PERM = false, AFTER_DRAIN = false;
    const float* xa; const float* xb; int split; float* out; const float* mod; int gate_off;
    __device__ __forceinline__ void operator()(const f32x4 (&acc)[2][2][4][2], const Unit& u, int wr, int wc, int fr, int fq) const {
        const int row0 = u.pm * BM + wr * 64 + fr, col0 = u.pn * BM + wc * 32 + 4 * fq;
        const int modi = u.pm < 16 ? 0 : 1 + ((u.pm - 16) >> 3);
        const float* g = mod + (size_t)modi * 6144 + gate_off + col0;
        f32x4 gv[2][2];
#pragma unroll
        for (int bj = 0; bj < 2; ++bj)
#pragma unroll
            for (int n = 0; n < 2; ++n) gv[bj][n] = *(const f32x4*)(g + bj * HALF + n * 16);
#pragma unroll
        for (int ai = 0; ai < 2; ++ai)
#pragma unroll
            for (int m = 0; m < 4; ++m) { const int row = row0 + ai * HALF + m * 16;
                const float* bp = (row < split ? xa + (size_t)row * 1024 : xb + (size_t)(row - split) * 1024) + col0; float* op = out + (size_t)row * 1024 + col0;
#pragma unroll
                for (int bj = 0; bj < 2; ++bj)
#pragma unroll
                    for (int n = 0; n < 2; ++n) { const f32x4 bs = *(const f32x4*)(bp + bj * HALF + n * 16); *(f32x4*)(op + bj * HALF + n * 16) = bs + gv[bj][n] * acc[ai][bj][m][n]; } }
    }
};
template <class Epi, class Sched, bool ALIGN_EPI = false, bool SP2 = false>
__device__ __forceinline__ void gemm_phase(PG8_LAS unsigned char* lds, const Gemm g, const Sched& S, const Epi& E) {
    const int tid = threadIdx.x, wid = __builtin_amdgcn_readfirstlane(tid >> 6), lane = tid & 63, wr = wid >> 2, wc = wid & 3, fr = lane & 15, fq = lane >> 4;
    const int K = g.K, nt = K / BK;
    unsigned voffA[2], voffB[2];
#pragma unroll
    for (int i = 0; i < 2; ++i) { int R, C; stage_rc(tid * 16 + i * 8192, R, C); const int Rb = Epi::PERM ? ((R & ~31) + perm32(R & 31)) : R;
        voffA[i] = (unsigned)(R * K + C) * 2u; voffB[i] = (unsigned)(Rb * K + C) * 2u; }
    const size_t kstep = (size_t)(BK * 2);
    const size_t hstep = (size_t)HALF * K * 2;
    const size_t tstep = 2 * hstep;
    const unsigned ldsw = (unsigned)wid * 1024u;
    const int aoff = lds_byte(wr * 64 + fr, fq * 8), boff = lds_byte(wc * 32 + fr, fq * 8);
#define PG8_SA(b, h) (((b) * 2 + (h)) * HTB)
#define PG8_SB(b, h) ((4 + (b) * 2 + (h)) * HTB)
#define PG8_STAGE(bufoff, gbase, voff) do { _Pragma("unroll") for (int _i = 0; _i < 2; ++_i) \
        __builtin_amdgcn_global_load_lds((const unsigned*)((const char*)(gbase) + (voff)[_i]), (PG8_LAS unsigned*)(lds + (bufoff) + ldsw + _i * 8192), 16, 0, 0); } while (0)
#define PG8_LDA(dst, b, h) do { _Pragma("unroll") for (int m = 0; m < 4; ++m) _Pragma("unroll") for (int k = 0; k < 2; ++k) dst[m][k] = *(const PG8_LAS bf16x8*)(lds + PG8_SA(b, h) + aoff + m * 2048 + k * 1024); } while (0)
#define PG8_LDB(dst, b, h) do { _Pragma("unroll") for (int n = 0; n < 2; ++n) _Pragma("unroll") for (int k = 0; k < 2; ++k) dst[n][k] = *(const PG8_LAS bf16x8*)(lds + PG8_SB(b, h) + boff + n * 2048 + k * 1024); } while (0)
#define PG8_MMA(ai, bj, At, Bt) do { __builtin_amdgcn_s_setprio(1); _Pragma("unroll") for (int m = 0; m < 4; ++m) _Pragma("unroll") for (int n = 0; n < 2; ++n) _Pragma("unroll") for (int k = 0; k < 2; ++k) \
        acc[ai][bj][m][n] = __builtin_amdgcn_mfma_f32_16x16x32_bf16(Bt[n][k], At[m][k], acc[ai][bj][m][n], 0, 0, 0); __builtin_amdgcn_s_setprio(0); } while (0)
#define PG8_WAIT_V(n) asm volatile("s_waitcnt vmcnt(" #n ")" ::: "memory")
#define PG8_WAIT_L(n) asm volatile("s_waitcnt lgkmcnt(" #n ")" ::: "memory")
#define PG8_BAR __builtin_amdgcn_s_barrier()
#define PG8_SCHED __builtin_amdgcn_sched_barrier(0)
    Unit cur, nxt; int ui = 0;
    if (!S.next(0, cur)) return;
    f32x4 acc[2][2][4][2];
#pragma unroll
    for (int a = 0; a < 2; ++a)
#pragma unroll
        for (int b = 0; b < 2; ++b)
#pragma unroll
            for (int m = 0; m < 4; ++m)
#pragma unroll
                for (int n = 0; n < 2; ++n) acc[a][b][m][n] = (f32x4){0.f, 0.f, 0.f, 0.f};
    bf16x8 At[4][2], B0[2][2], B1[2][2];
    const char* cA = (const char*)g.A + (size_t)cur.pm * tstep; const char* cB = (const char*)g.Bt + (size_t)cur.pn * tstep;
    S.a_ready(cur);
    if constexpr (SP2) {
        PG8_STAGE(PG8_SB(0, 0), cB, voffB); PG8_STAGE(PG8_SB(0, 1), cB + hstep, voffB); PG8_STAGE(PG8_SA(0, 0), cA, voffA); PG8_STAGE(PG8_SA(0, 1), cA + hstep, voffA);
        if (wr == 1) PG8_BAR;
        PG8_WAIT_V(2); PG8_BAR;
        PG8_STAGE(PG8_SB(1, 0), cB + kstep, voffB); PG8_STAGE(PG8_SA(1, 0), cA + kstep, voffA); PG8_STAGE(PG8_SB(1, 1), cB + hstep + kstep, voffB);
        PG8_WAIT_V(6); PG8_BAR;
    } else {
        PG8_STAGE(PG8_SB(0, 0), cB, voffB); PG8_STAGE(PG8_SA(0, 0), cA, voffA); PG8_STAGE(PG8_SB(0, 1), cB + hstep, voffB); PG8_STAGE(PG8_SA(0, 1), cA + hstep, voffA);
        if (wr == 1) PG8_BAR;
        PG8_WAIT_V(4); PG8_BAR;
        PG8_STAGE(PG8_SB(1, 0), cB + kstep, voffB); PG8_STAGE(PG8_SA(1, 0), cA + kstep, voffA); PG8_STAGE(PG8_SB(1, 1), cB + hstep + kstep, voffB);
        PG8_WAIT_V(6); PG8_BAR;
    }
    for (;;) {
        const bool has_next = S.next(ui + 1, nxt);
        const char* nA = has_next ? (const char*)g.A + (size_t)nxt.pm * tstep : cA; const char* nB = has_next ? (const char*)g.Bt + (size_t)nxt.pn * tstep : cB;
        for (int t = 0; t < nt; t += 2) {
            const bool last = (t == nt - 2);
            const char* a1 = cA + (size_t)(t + 1) * kstep;
            const char* a2 = last ? nA : cA + (size_t)(t + 2) * kstep; const char* b2 = last ? nB : cB + (size_t)(t + 2) * kstep;
            const char* a3 = a2 + kstep; const char* b3 = b2 + kstep;
            if (last && has_next) S.a_ready(nxt);
            if constexpr (SP2) {
            PG8_LDB(B0, 0, 0); PG8_LDB(B1, 0, 1); PG8_SCHED; PG8_LDA(At, 0, 0); PG8_STAGE(PG8_SA(1, 1), a1 + hstep, voffA);
            PG8_WAIT_V(8); PG8_WAIT_L(0); PG8_BAR; PG8_MMA(0, 0, At, B0); PG8_MMA(0, 1, At, B1); PG8_BAR; PG8_SCHED;
            PG8_LDA(At, 0, 1); PG8_STAGE(PG8_SB(0, 0), b2, voffB); PG8_STAGE(PG8_SB(0, 1), b2 + hstep, voffB); PG8_STAGE(PG8_SA(0, 0), a2, voffA);
            PG8_WAIT_V(8); PG8_WAIT_L(0); PG8_BAR; PG8_MMA(1, 0, At, B0); PG8_MMA(1, 1, At, B1); PG8_BAR; PG8_SCHED;
            PG8_LDB(B0, 1, 0); PG8_LDB(B1, 1, 1); PG8_SCHED; PG8_LDA(At, 1, 0); PG8_STAGE(PG8_SA(0, 1), a2 + hstep, voffA);
            PG8_WAIT_V(8); PG8_WAIT_L(0); PG8_BAR; PG8_MMA(0, 0, At, B0); PG8_MMA(0, 1, At, B1); PG8_BAR; PG8_SCHED;
            PG8_LDA(At, 1, 1); PG8_STAGE(PG8_SB(1, 0), b3, voffB); PG8_STAGE(PG8_SB(1, 1), b3 + hstep, voffB); PG8_STAGE(PG8_SA(1, 0), a3, voffA);
            PG8_WAIT_V(8); PG8_WAIT_L(0); PG8_BAR; PG8_MMA(1, 0, At, B0); PG8_MMA(1, 1, At, B1); PG8_BAR; PG8_SCHED;
            } else {
            PG8_LDB(B0, 0, 0); PG8_SCHED; PG8_LDA(At, 0, 0); PG8_STAGE(PG8_SA(1, 1), a1 + hstep, voffA);
            PG8_WAIT_L(8); PG8_BAR; PG8_WAIT_L(0); PG8_MMA(0, 0, At, B0); PG8_BAR; PG8_SCHED;
            PG8_LDB(B1, 0, 1); PG8_STAGE(PG8_SB(0, 0), b2, voffB);
            PG8_BAR; PG8_WAIT_L(0); PG8_MMA(0, 1, At, B1); PG8_BAR;
            PG8_LDA(At, 0, 1); PG8_STAGE(PG8_SA(0, 0), a2, voffA);
            PG8_BAR; PG8_WAIT_L(0); PG8_MMA(1, 0, At, B0); PG8_BAR; PG8_SCHED;
            PG8_STAGE(PG8_SB(0, 1), b2 + hstep, voffB);
            PG8_WAIT_V(6); PG8_BAR; PG8_MMA(1, 1, At, B1); PG8_BAR;
            PG8_LDB(B0, 1, 0); PG8_SCHED; PG8_LDA(At, 1, 0); PG8_STAGE(PG8_SA(0, 1), a2 + hstep, voffA);
            PG8_WAIT_L(8); PG8_BAR; PG8_WAIT_L(0); PG8_MMA(0, 0, At, B0); PG8_BAR; PG8_SCHED;
            PG8_LDB(B1, 1, 1); PG8_STAGE(PG8_SB(1, 0), b3, voffB);
            PG8_BAR; PG8_WAIT_L(0); PG8_MMA(0, 1, At, B1); PG8_BAR;
            PG8_LDA(At, 1, 1); PG8_STAGE(PG8_SA(1, 0), a3, voffA);
            PG8_BAR; PG8_WAIT_L(0); PG8_MMA(1, 0, At, B0); PG8_BAR; PG8_SCHED;
            PG8_STAGE(PG8_SB(1, 1), b3 + hstep, voffB);
            PG8_WAIT_V(6); PG8_BAR; PG8_MMA(1, 1, At, B1); PG8_BAR;
            }
        }
        if constexpr (ALIGN_EPI) { if (wr == 0) PG8_BAR; }
        if constexpr (!Epi::AFTER_DRAIN) { E(acc, cur, wr, wc, fr, fq); S.done(cur); }
        if (!has_next) break;
#pragma unroll
        for (int a = 0; a < 2; ++a)
#pragma unroll
            for (int b = 0; b < 2; ++b)
#pragma unroll
                for (int m = 0; m < 4; ++m)
#pragma unroll
                    for (int n = 0; n < 2; ++n) acc[a][b][m][n] = (f32x4){0.f, 0.f, 0.f, 0.f};
        cur = nxt; cA = nA; cB = nB; ++ui;
        if constexpr (ALIGN_EPI) { if (wr == 1) PG8_BAR; }
    }
    PG8_WAIT_V(0);
    if constexpr (!ALIGN_EPI) { if (wr == 0) PG8_BAR; }
    PG8_BAR;
    if constexpr (Epi::AFTER_DRAIN) { E.fused(acc, cur, wr, wc, fr, fq, lds, wid, lane); S.done(cur); }
#undef PG8_SA
#undef PG8_SB
#undef PG8_STAGE
#undef PG8_LDA
#undef PG8_LDB
#undef PG8_MMA
#undef PG8_WAIT_V
#undef PG8_WAIT_L
#undef PG8_BAR
#undef PG8_SCHED
}
}
#define XB_TMO      128
#define XB_XCNT(j)  (256  + 64 * (j))
#define XB_XSUB(j)  (1280 + 64 * (j))
#define XB_XGEN(j)  (2304 + 64 * (j))
#define XB_TOP      3328
#define XB_TOPGEN   3392
#define XCD_BAR_WORDS 3456
#define XB_SPIN_CAP (1u << 18)

__device__ __forceinline__ unsigned xb_ld(unsigned* p)              { return __hip_atomic_load(p, __ATOMIC_RELAXED, __HIP_MEMORY_SCOPE_AGENT); }
__device__ __forceinline__ unsigned xb_add(unsigned* p, unsigned v) { return __hip_atomic_fetch_add(p, v, __ATOMIC_RELAXED, __HIP_MEMORY_SCOPE_AGENT); }
__device__ __forceinline__ unsigned xb_xcc_id() { return (unsigned)__builtin_amdgcn_s_getreg((3 << 11) | 20) & 0xFu; }
#define XB_SPIN(cond, bar) do { unsigned _sp = 0; while (cond) { __builtin_amdgcn_s_sleep(1); \
    if ((++_sp & 255u) == 0u) { if (xb_ld(&(bar)[XB_TMO])) break; if (_sp > XB_SPIN_CAP) { atomicAdd(&(bar)[XB_TMO], 1u); break; } } } } while (0)

struct XcdBarrier {
    unsigned* bar; unsigned x;
    volatile LAS unsigned* st;
};

__device__ __forceinline__ XcdBarrier xcd_barrier_post(unsigned* bar, volatile LAS unsigned* st) {
    XcdBarrier b; b.bar = bar; b.x = xb_xcc_id(); b.st = st;
    if (threadIdx.x == 0) (void)xb_add(&bar[XB_XCNT(b.x)], 1u);
    return b;
}
__device__ __forceinline__ void xcd_barrier_complete(unsigned* bar, unsigned x, unsigned& nloc, unsigned& nx) {
    const unsigned G = gridDim.x * gridDim.y * gridDim.z;
    unsigned sum, cnt, mine, sp = 0u;
    for (;;) {
        sum = 0u; cnt = 0u; mine = 0u;
#pragma unroll
        for (unsigned j = 0; j < 16; ++j) { const unsigned c = xb_ld(&bar[XB_XCNT(j)]); sum += c; cnt += (c > 0u) ? 1u : 0u; mine = (j == x) ? c : mine; }
        if (sum == G) break;
        __builtin_amdgcn_s_sleep(1);
        if ((++sp & 255u) == 0u) { if (xb_ld(&bar[XB_TMO])) break; if (sp > XB_SPIN_CAP) { atomicAdd(&bar[XB_TMO], 1u); break; } }
    }
    nloc = mine > 0u ? mine : 1u; nx = cnt > 0u ? cnt : 1u;
}

__device__ __forceinline__ void xcd_barrier(const XcdBarrier& b) {
    asm volatile("s_waitcnt vmcnt(0)" ::: "memory");
    __syncthreads();
    if (threadIdx.x == 0) {
        unsigned* bar = b.bar;
        __builtin_amdgcn_s_waitcnt(0);
        unsigned nloc = b.st[0], nx = b.st[1];
        if (nloc == 0u) { xcd_barrier_complete(bar, b.x, nloc, nx); b.st[0] = nloc; b.st[1] = nx; }
        const unsigned old = xb_add(&bar[XB_XSUB(b.x)], 1u);
        const unsigned gen = old / nloc;
        if (old + 1u == (gen + 1u) * nloc) {
            __builtin_amdgcn_fence(__ATOMIC_RELEASE, "agent");
            asm volatile("s_waitcnt vmcnt(0)" ::: "memory");
            const unsigned og = xb_add(&bar[XB_TOP], 1u);
            const unsigned tg = og / nx;
            if (og + 1u == (tg + 1u) * nx) xb_add(&bar[XB_TOPGEN], 1u);
            else XB_SPIN(xb_ld(&bar[XB_TOPGEN]) == tg, bar);
            __builtin_amdgcn_fence(__ATOMIC_ACQUIRE, "agent");
            xb_add(&bar[XB_XGEN(b.x)], 1u);
            asm volatile("s_waitcnt vmcnt(0)" ::: "memory");
        } else {
            XB_SPIN(xb_ld(&bar[XB_XGEN(b.x)]) == gen, bar);
            __builtin_amdgcn_fence(__ATOMIC_ACQUIRE, "agent");
            asm volatile("s_waitcnt vmcnt(0)" ::: "memory");
        }
    }
    __syncthreads();
}

constexpr int NWAVES = 8;
constexpr int RING_BYTES = 131072, LDSCTL_OFF = RING_BYTES, MISC_OFF = LDSCTL_OFF + 320, LDS_BYTES = 147456;
constexpr size_t CTL_ZERO_BYTES = 1 * MiB;
constexpr int CW_BAR = 4096;
constexpr size_t WS_MODP = WS_MOD + 256 * 1024;
#define LDS_WAIT() asm volatile("s_waitcnt lgkmcnt(0)" ::: "memory")
#define VM_WAIT() asm volatile("s_waitcnt vmcnt(0)" ::: "memory")
typedef unsigned v4u __attribute__((ext_vector_type(4)));
__device__ __forceinline__ unsigned pk2(float lo, float hi) { return f2bf(lo) | (f2bf(hi) << 16); }
__device__ __forceinline__ float wave_sum(float v) {
#pragma unroll
    for (int o = 1; o < 64; o <<= 1) v += __shfl_xor(v, o);
    return v;
}

struct SrcPlain { const float* W; int N; __device__ __forceinline__ float operator()(int k, int n) const { return W[(size_t)k * N + n]; } };
struct SrcFold { const float *mu_wag, *w1, *a1, *g1, *gk1;
    __device__ __forceinline__ float operator()(int k, int j) const {
        float v = 0.f;
        if (j < 768) { const int part = j >> 7, c = j & 127, which = part % 3; const bool bpart = part >= 3;
            const float mu = mu_wag[which * D + k], f = bpart ? mu : 1.f - mu; float w;
            if (which == 0) w = w1[((size_t)(c >> 6) * D + k) * 64 + (c & 63)];
            else if (which == 1) w = a1[((size_t)(c >> 6) * D + k) * 64 + (c & 63)];
            else w = g1[(size_t)k * 128 + c];
            v = f * w;
        } else if (j < 800) { const int c = j - 768; v = gk1[((size_t)(c >> 4) * D + k) * 16 + (c & 15)]; }
        return v; } };
template <class Src> __device__ __forceinline__ void p0_transpose_item(const Src& src, int K, int nblk, bf16_t* WT, int row_off, LAS float* scr, int item, int lane) {
    const int kb = item / nblk, nb = item % nblk, k0 = 64 * kb, n0 = 32 * nb;
#pragma unroll 8
    for (int i = 0; i < 32; ++i) { const int kk = 2 * i + (lane >> 5); scr[kk * 33 + (lane & 31)] = src(k0 + kk, n0 + (lane & 31)); }
    LDS_WAIT(); asm volatile("" ::: "memory");
    const int c = lane & 7;
#pragma unroll
    for (int j = 0; j < 4; ++j) { const int n = (lane >> 3) + 8 * j; const LAS float* s = scr + (8 * c) * 33 + n;
        v4u o; o.x = pk2(s[0 * 33], s[1 * 33]); o.y = pk2(s[2 * 33], s[3 * 33]); o.z = pk2(s[4 * 33], s[5 * 33]); o.w = pk2(s[6 * 33], s[7 * 33]);
        *(v4u*)(WT + (size_t)(row_off + n0 + n) * K + k0 + 8 * c) = o; }
    LDS_WAIT(); asm volatile("" ::: "memory");
}
__device__ __forceinline__ void p0_mod_task(const float* c, const float* c_ctx, const float* ada_w, float* MODP, LAS float* scr, int task, int lane) {
    const int cg = task >> 2, ks = task & 3, col = cg * 64 + lane, k0 = ks * 256;
    for (int e = lane; e < 5 * 256; e += 64) { const int b = e >> 8, kk = e & 255; const float x = (b == 0 ? c_ctx : c + (size_t)(b - 1) * D)[k0 + kk]; scr[kk * 8 + b] = x * sigmoidf_(x); }
    LDS_WAIT(); asm volatile("" ::: "memory");
    float a0 = 0.f, a1 = 0.f, a2 = 0.f, a3 = 0.f, a4 = 0.f;
    const float* wp = ada_w + (size_t)k0 * NMOD + col;
#pragma unroll 8
    for (int kk = 0; kk < 256; ++kk) { const float w = wp[(size_t)kk * NMOD]; const f32x4 t = *(const LAS f32x4*)(scr + kk * 8); const float t4 = scr[kk * 8 + 4];
        a0 += t.x * w; a1 += t.y * w; a2 += t.z * w; a3 += t.w * w; a4 += t4 * w; }
    float* o = MODP + (size_t)(ks * 5) * NMOD + col;
    o[0] = a0; o[NMOD] = a1; o[2 * NMOD] = a2; o[3 * NMOD] = a3; o[4 * NMOD] = a4;
    LDS_WAIT(); asm volatile("" ::: "memory");
}
__device__ __forceinline__ void norm_row_bf16(const float* xrow, bf16_t* orow, const LAS float* tg, const LAS float* ts, int lane) {
    const f32x4* xr = (const f32x4*)xrow + lane;
    f32x4 v[4]; float s = 0.f;
#pragma unroll
    for (int j = 0; j < 4; ++j) { v[j] = xr[64 * j]; s += (v[j].x * v[j].x + v[j].y * v[j].y) + (v[j].z * v[j].z + v[j].w * v[j].w); }
    const float rs = rsqrtf(wave_sum(s) * (1.f / D) + 1e-6f);
    unsigned long long* o8 = (unsigned long long*)orow + lane;
#pragma unroll
    for (int j = 0; j < 4; ++j) { const f32x4 g = *(const LAS f32x4*)(tg + 4 * lane + 256 * j), sh = *(const LAS f32x4*)(ts + 4 * lane + 256 * j);
        const f32x4 y = v[j] * rs * g + sh; o8[64 * j] = (unsigned long long)pk2(y.x, y.y) | ((unsigned long long)pk2(y.z, y.w) << 32); }
}

struct Args { const float* in[36]; float* out; unsigned char* ws; int ph_lo, ph_hi, li, pad; };

__global__ void __launch_bounds__(NWAVES * 64, 2) mega_fwd(Args args) {
    extern __shared__ __attribute__((aligned(16))) unsigned char lds_raw[];
    LAS unsigned char* lds = (LAS unsigned char*)lds_raw;
    volatile LAS unsigned* MISC = (volatile LAS unsigned*)(lds + MISC_OFF);
    const int tid = threadIdx.x, lane = tid & 63, wave = __builtin_amdgcn_readfirstlane(tid >> 6);
    const int G = gridDim.x, bx = blockIdx.x; const int vcu = (G % 8 == 0) ? (bx % 8) * (G / 8) + bx / 8 : bx;
    const int gw = vcu * NWAVES + wave, NGW = G * NWAVES;
    unsigned char* ws = args.ws; float* outf = args.out; unsigned char* dout = (unsigned char*)args.out;
    for (int u = tid; u < (LDS_BYTES - LDSCTL_OFF) / 4; u += NWAVES * 64) ((LAS unsigned*)(lds + LDSCTL_OFF))[u] = 0u;
    __syncthreads();
    XcdBarrier bar = xcd_barrier_post((unsigned*)ws + CW_BAR + args.li * XCD_BAR_WORDS, MISC + 8);
    const int lo = args.ph_lo, hi = args.ph_hi;
#define IN(k) (lo <= (k) && (k) < hi)
#define SEAM(k) do { if (IN(k) && IN((k) + 1)) xcd_barrier(bar); } while (0)

    const float* x_prompt = args.in[0]; const float* x_sample = args.in[1];
    bf16_t* WC1T = (bf16_t*)(ws + WS_WC1T); bf16_t* WOT = (bf16_t*)(ws + WS_WOT); bf16_t* W1T = (bf16_t*)(ws + WS_W1T); bf16_t* W2T = (bf16_t*)(ws + WS_W2T);
    float* MOD = (float*)(ws + WS_MOD); float* MODP = (float*)(ws + WS_MODP);
    bf16_t* XN = (bf16_t*)(ws + WS_XN); bf16_t* MIX = XN; bf16_t* PROJ = (bf16_t*)(ws + WS_PROJ); bf16_t* HB = PROJ; bf16_t* XN2 = (bf16_t*)(ws + WS_SCAN);

    if (IN(0)) {
        LAS float* scr = (LAS float*)(lds + wave * 16384);
        constexpr int I_MOD = 96 * 4, I_IN = 16 * 96, I_FOLD = 16 * 32, I_O = 16 * 32, I_1 = 16 * 128, I_2 = 64 * 32;
        constexpr int NITEMS = I_MOD + I_IN + I_FOLD + I_O + I_1 + I_2;
        const SrcPlain s_in{args.in[12], 3072}, s_o{args.in[32], D}, s_1{args.in[33], FF}, s_2{args.in[34], D};
        const SrcFold s_f{args.in[14], args.in[16], args.in[19], args.in[21], args.in[28]};
        for (int it = gw; it < NITEMS; it += NGW) {
            int r = it;
            if (r < I_MOD) { p0_mod_task(args.in[2], args.in[7], args.in[8], MODP, scr, r, lane); continue; } r -= I_MOD;
            if (r < I_IN) { p0_transpose_item(s_in, D, 96, WC1T, 0, scr, r, lane); continue; } r -= I_IN;
            if (r < I_FOLD) { p0_transpose_item(s_f, D, 32, WC1T, LA, scr, r, lane); continue; } r -= I_FOLD;
            if (r < I_O) { p0_transpose_item(s_o, D, 32, WOT, 0, scr, r, lane); continue; } r -= I_O;
            if (r < I_1) { p0_transpose_item(s_1, D, 128, W1T, 0, scr, r, lane); continue; } r -= I_1;
            p0_transpose_item(s_2, FF, 32, W2T, 0, scr, r, lane);
        }
    }
    SEAM(0);
    if (IN(1)) {
        const float* ada_b = args.in[9]; const float* g1n = args.in[10];
        LAS float* TG = (LAS float*)lds; LAS float* TS = TG + 5 * 1024;
        for (int e = tid; e < 5 * 1024; e += NWAVES * 64) { const int b = e >> 10, c = e & 1023; float sh = ada_b[c], sc = ada_b[D + c];
#pragma unroll
            for (int ks = 0; ks < 4; ++ks) { sh += MODP[(size_t)(ks * 5 + b) * NMOD + c]; sc += MODP[(size_t)(ks * 5 + b) * NMOD + D + c]; }
            TG[e] = g1n[c] * (1.f + sc); TS[e] = sh; }
        for (int e = bx * (NWAVES * 64) + tid; e < 5 * NMOD; e += G * NWAVES * 64) { const int b = e / NMOD, c = e % NMOD; float v = ada_b[c];
#pragma unroll
            for (int ks = 0; ks < 4; ++ks) v += MODP[(size_t)(ks * 5 + b) * NMOD + c];
            MOD[e] = v; }
        __syncthreads();
        for (int m = gw; m < M; m += NGW) { const int modi = m < M_P ? 0 : 1 + ((m - M_P) >> 11);
            norm_row_bf16(m < M_P ? x_prompt + (size_t)m * D : x_sample + (size_t)(m - M_P) * D, XN + (size_t)m * D, TG + modi * 1024, TS + modi * 1024, lane); }
        __syncthreads();
    }
    SEAM(1);
    if (IN(2)) {
        pg8::Gemm g{XN, WC1T, M, N1, D}; pg8::StaticOrder S; S.init(M, N1, G, bx);
        pg8::EpiBf16<0> E{PROJ, N1};
        pg8::gemm_phase<pg8::EpiBf16<0>, pg8::StaticOrder, true, true>(lds, g, S, E);
    }
    SEAM(2);
    SEAM(3); SEAM(4); SEAM(5);
    if (IN(6)) {
        pg8::Gemm g{MIX, WOT, M, D, D}; pg8::StaticOrder S; S.init(M, D, G, bx);
        pg8::EpiGateRes E{x_prompt, x_sample, M_P, outf, MOD, 2 * D};
        pg8::gemm_phase<pg8::EpiGateRes, pg8::StaticOrder, false, true>(lds, g, S, E);
    }
    SEAM(6);
    if (IN(7)) {
        const float* g2n = args.in[11];
        LAS float* TG = (LAS float*)lds; LAS float* TS = TG + 5 * 1024;
        for (int e = tid; e < 5 * 1024; e += NWAVES * 64) { const int b = e >> 10, c = e & 1023; TG[e] = g2n[c] * (1.f + MOD[(size_t)b * NMOD + 4 * D + c]); TS[e] = MOD[(size_t)b * NMOD + 3 * D + c]; }
        __syncthreads();
        for (int m = gw; m < M; m += NGW) { const int modi = m < M_P ? 0 : 1 + ((m - M_P) >> 11);
            norm_row_bf16(outf + (size_t)m * D, XN2 + (size_t)m * D, TG + modi * 1024, TS + modi * 1024, lane); }
        __syncthreads();
    }
    SEAM(7);
    if (IN(8)) {
        pg8::Gemm g{XN2, W1T, M, FF, D}; pg8::StaticOrder S; S.init(M, FF, G, bx);
        pg8::EpiBf16<2> E{HB, FF};
        pg8::gemm_phase<pg8::EpiBf16<2>, pg8::StaticOrder, true, true>(lds, g, S, E);
    }
    SEAM(8);
    if (IN(9)) {
        pg8::Gemm g{HB, W2T, M, D, FF}; pg8::StaticOrder S; S.init(M, D, G, bx);
        pg8::EpiGateRes E{outf, outf, M, outf, MOD, 5 * D};
        pg8::gemm_phase<pg8::EpiGateRes, pg8::StaticOrder, false, true>(lds, g, S, E);
    }
    SEAM(9);
    if (IN(10)) {
        const float* gf = args.in[35];
        f32x4 gv[4];
#pragma unroll
        for (int j = 0; j < 4; ++j) gv[j] = *((const f32x4*)gf + lane + 64 * j);
        for (int m = gw; m < M; m += NGW) { f32x4* xr = (f32x4*)(outf + (size_t)m * D) + lane; f32x4 v[4]; float s = 0.f;
#pragma unroll
            for (int j = 0; j < 4; ++j) { v[j] = xr[64 * j]; s += (v[j].x * v[j].x + v[j].y * v[j].y) + (v[j].z * v[j].z + v[j].w * v[j].w); }
            const float rs = rsqrtf(wave_sum(s) * (1.f / D) + 1e-6f);
#pragma unroll
            for (int j = 0; j < 4; ++j) xr[64 * j] = v[j] * rs * gv[j]; }
    }
#undef IN
#undef SEAM
}

extern "C" void kernel_launch(void* const* d_in, const int* in_sizes, int n_in, void* d_out, int out_size, void* d_ws, size_t ws_size, hipStream_t stream) {
    static int grid = 0;
    if (grid == 0) {
        int dev = 0, cus = 0;
        if (hipGetDevice(&dev) != hipSuccess || hipDeviceGetAttribute(&cus, hipDeviceAttributeMultiprocessorCount, dev) != hipSuccess) { fprintf(stderr, "kernel_launch: device query failed\n"); grid = -1; return; }
        if (hipFuncSetAttribute((const void*)mega_fwd, hipFuncAttributeMaxDynamicSharedMemorySize, LDS_BYTES) != hipSuccess) { fprintf(stderr, "kernel_launch: hipFuncSetAttribute failed\n"); grid = -1; return; }
        int per_cu = 0;
        if (hipOccupancyMaxActiveBlocksPerMultiprocessor(&per_cu, (const void*)mega_fwd, NWAVES * 64, LDS_BYTES) != hipSuccess || per_cu < 1) fprintf(stderr, "kernel_launch: occupancy query reports %d\n", per_cu);
        (void)hipGetLastError();
        grid = cus;
    }
    if (grid < 0) return;
    const float* srf = (const float*)d_in[3]; const float* srb = (const float*)d_in[4]; const float* sgf = (const float*)d_in[5]; const float* sgb = (const float*)d_in[6];
    const float* mu_rkv = (const float*)d_in[13]; const float* w0 = (const float*)d_in[15];
    const float* w2 = (const float*)d_in[17]; const float* a0 = (const float*)d_in[18];
    const float* a2 = (const float*)d_in[20]; const float* g2 = (const float*)d_in[22];
    const float* k_k = (const float*)d_in[23]; const float* k_a = (const float*)d_in[24]; const float* r_k = (const float*)d_in[25];
    const float* lnx_g = (const float*)d_in[26]; const float* lnx_b = (const float*)d_in[27];
    const float* gk2 = (const float*)d_in[29]; const float* gk_b = (const float*)d_in[30]; const float* gla_g = (const float*)d_in[31];
    unsigned char* ws = (unsigned char*)d_ws; unsigned char* dout = (unsigned char*)d_out; float* outf = (float*)d_out;
    bf16_t* XN = (bf16_t*)(ws + WS_XN); bf16_t* MIX = XN; bf16_t* PROJ = (bf16_t*)(ws + WS_PROJ);
    bf16_t* SCAN = (bf16_t*)(ws + WS_SCAN);
    bf16_t* LGF = (bf16_t*)(dout + DO_LGF); bf16_t* LGB = (bf16_t*)(dout + DO_LGB); bf16_t* OF = (bf16_t*)(dout + DO_OF); bf16_t* OB = (bf16_t*)(dout + DO_OB); bf16_t* GATE = (bf16_t*)(dout + DO_GATE);
    float* OS_RF = outf + (size_t)M * D; float* OS_RB = OS_RF + 524288; float* OS_GF = OS_RB + 524288; float* OS_GB = OS_GF + 524288;

    (void)hipMemsetAsync(d_ws, 0, CTL_ZERO_BYTES, stream);
    Args a{};
    for (int i = 0; i < 36; ++i) a.in[i] = (const float*)d_in[i];
    a.out = outf; a.ws = ws;
    a.ph_lo = 0; a.ph_hi = 3; a.li = 0;
    hipLaunchKernelGGL(mega_fwd, dim3(grid), dim3(NWAVES * 64), LDS_BYTES, stream, a);
    { PrepArgs p{}; p.proj = PROJ; p.scan = SCAN; p.lgf = LGF; p.lgb = LGB; p.gate = GATE; p.mu_rkv = mu_rkv; p.w0 = w0; p.w2 = w2; p.a0 = a0; p.a2 = a2; p.g2 = g2; p.k_k = k_k; p.gk2 = gk2; p.gk_b = gk_b;
      k_prep<<<M, 256, 0, stream>>>(p); }
    { RwkvArgs p{}; p.scan = SCAN; p.k_a = k_a; p.s_f = srf; p.s_b = srb; p.os_f = OS_RF; p.os_b = OS_RB; k_rwkv<<<(NB_P + NB_S) * NH * 2, 64, 0, stream>>>(p); }
    { GlaArgs p{}; p.proj = PROJ; p.lgf = LGF; p.lgb = LGB; p.of = OF; p.ob = OB; p.s_f = sgf; p.s_b = sgb; p.os_f = OS_GF; p.os_b = OS_GB; k_gla<<<(NB_P + NB_S) * GH * 2, 128, 0, stream>>>(p); }
    { CombArgs p{}; p.scan = SCAN; p.gate = GATE; p.of = OF; p.ob = OB; p.proj = PROJ; p.mix = MIX; p.k_a = k_a; p.r_k = r_k; p.lnx_g = lnx_g; p.lnx_b = lnx_b; p.gla_g = gla_g;
      k_combine<<<M, 256, 0, stream>>>(p); }
    a.ph_lo = 6; a.ph_hi = 11; a.li = 1;
    hipLaunchKernelGGL(mega_fwd, dim3(grid), dim3(NWAVES * 64), LDS_BYTES, stream, a);
}
```

```cpp
#include <hip/hip_runtime.h>
#include <stdint.h>
#include <cstdio>

typedef unsigned short bf16_t;
typedef short bf16x8 __attribute__((ext_vector_type(8)));
typedef float f32x4 __attribute__((ext_vector_type(4)));

constexpr int D = 1024, NB_P = 16, L_P = 256, NB_S = 4, L_S = 2048;
constexpr int M_P = NB_P * L_P, M_S = NB_S * L_S, M = M_P + M_S;
constexpr int RW = 512, NH = 8, HD = 64, GH = 4, GKD = 64, GVD = 128, GQK = 256;
constexpr int FF = 4096, N1 = 4096, LA = 3072, NMOD = 6 * D;
constexpr int GRID_W = 64, NGRP = M / 16;
constexpr int C_GQ = 1536, C_GK = 1792, C_GV = 2048, C_GG = 2560, C_GATE = 2048;

constexpr size_t MiB = 1u << 20;
constexpr size_t WS_WC1T = 1 * MiB, WS_WOT = 9 * MiB, WS_W1T = 11 * MiB, WS_W2T = 19 * MiB;
constexpr size_t WS_MOD = 27 * MiB;
constexpr size_t WS_XN = 29 * MiB;
constexpr size_t WS_PROJ = 53 * MiB;
constexpr size_t WS_R1 = 149 * MiB;
constexpr size_t WS_RA = 149 * MiB, WS_RR = 173 * MiB, WS_RBK = 197 * MiB, WS_RGC = 245 * MiB, WS_GGC = 248 * MiB, WS_GATT = 249 * MiB + 512 * 1024;
constexpr size_t WS_GQ = 29 * MiB, WS_GKT = 41 * MiB, WS_RV = 11 * MiB;
constexpr size_t DO_BG = 0, DO_RSM = 12 * MiB, DO_GV = 36 * MiB;

__device__ __forceinline__ unsigned f2bf(float f) { unsigned u = __builtin_bit_cast(unsigned, f); return (u + 0x7fffu + ((u >> 16) & 1u)) >> 16; }
__device__ __forceinline__ float bf2f(bf16_t h) { return __builtin_bit_cast(float, (unsigned)h << 16); }
__device__ __forceinline__ float sigmoidf_(float x) { return 1.f / (1.f + __expf(-x)); }
__device__ __forceinline__ float log_sigmoidf_(float x) { return fminf(x, 0.f) - log1pf(__expf(-fabsf(x))); }

struct Tok { int b, t, L, base, modi; bool sample; };
__device__ __forceinline__ Tok tok_of(int m) {
    Tok k;
    if (m < M_P) { k.b = m / L_P; k.t = m % L_P; k.L = L_P; k.base = k.b * L_P; k.modi = 0; k.sample = false; }
    else { int q = m - M_P; k.b = q / L_S; k.t = q % L_S; k.L = L_S; k.base = M_P + k.b * L_S; k.modi = 1 + k.b; k.sample = true; }
    return k;
}
struct Nb { int n0, n1, n2, n3; float wgt; };
__device__ __forceinline__ Nb shift_nb(const Tok& k) {
    Nb r; r.n0 = r.n1 = r.n2 = r.n3 = -1;
    if (!k.sample) { r.wgt = 0.5f; if (k.t > 0) r.n0 = k.base + k.t - 1; if (k.t < k.L - 1) r.n1 = k.base + k.t + 1; }
    else { r.wgt = 0.25f; const int row = k.t / GRID_W, col = k.t % GRID_W;
        if (row > 0) r.n0 = k.base + k.t - GRID_W; if (row < L_S / GRID_W - 1) r.n1 = k.base + k.t + GRID_W;
        if (col > 0) r.n2 = k.base + k.t - 1; if (col < GRID_W - 1) r.n3 = k.base + k.t + 1; }
    return r;
}

#define LAS __attribute__((address_space(3)))
namespace pg8 {
#define PG8_LAS __attribute__((address_space(3)))
typedef unsigned short bf16_t;
typedef short bf16x8 __attribute__((ext_vector_type(8)));
typedef float f32x4 __attribute__((ext_vector_type(4)));
typedef unsigned u32x4 __attribute__((ext_vector_type(4)));
constexpr int BM = 256, BK = 64, HALF = 128, HTB = HALF * BK * 2  , STAGE_BYTES = 8 * HTB, NXCD = 8, WGM = 8;

__host__ __device__ __forceinline__ int lds_byte(int r, int c) { const int st = (r >> 4) * 2 + (c >> 5), rr = r & 15, cc = c & 31, ob = rr * 64 + cc * 2; return st * 1024 + (ob ^ (((ob >> 9) & 1) << 5)); }
__host__ __device__ __forceinline__ void stage_rc(int b, int& R, int& C) { const int st = b / 1024, sb = b % 1024, swz = sb ^ (((sb >> 9) & 1) << 5); R = (st >> 1) * 16 + swz / 64; C = (st & 1) * 32 + (swz % 64) / 2; }
__host__ __device__ __forceinline__ int perm32(int rho) { const int n = rho >> 4, i = rho & 15; return 8 * (i >> 2) + 4 * n + (i & 3); }

struct Unit { int pm, pn; };
struct Gemm { const bf16_t* A; const bf16_t* Bt; int M, N, K; };

struct StaticOrder {
    int nM, nN, nwg, G, c;
    __host__ __device__ void init(int M, int N, int G_, int c_) { nM = M / BM; nN = N / BM; nwg = nM * nN; G = G_; c = c_; }
    __host__ __device__ bool next(int i, Unit& u) const {
        const long L = (long)i * G + c; if (L >= nwg) return false;
        int wgid = (int)L; { const int q = nwg / NXCD, r = nwg % NXCD, xcd = wgid % NXCD, off = wgid / NXCD; wgid = (xcd < r ? xcd * (q + 1) : r * (q + 1) + (xcd - r) * q) + off; }
        const int nig = WGM * nN, gid = wgid / nig, fm = gid * WGM, gsz = (nM - fm) < WGM ? (nM - fm) : WGM;
        u.pm = fm + ((wgid % nig) % gsz); u.pn = (wgid % nig) / gsz; return true;
    }
    __device__ __forceinline__ void a_ready(const Unit&) const {}
    __device__ __forceinline__ void done(const Unit&) const {}
};

typedef float cvt_f32x2 __attribute__((ext_vector_type(2))); typedef __bf16 cvt_bf16x2 __attribute__((ext_vector_type(2)));
__device__ __forceinline__ unsigned cvt_pk_bf16(float lo, float hi) { const cvt_f32x2 v = {lo, hi}; const cvt_bf16x2 b = __builtin_convertvector(v, cvt_bf16x2); return __builtin_bit_cast(unsigned, b); }
typedef float f32x2 __attribute__((ext_vector_type(2)));
template <int ACT  > struct EpiBf16 {
    static constexpr bool PERM = true, AFTER_DRAIN = false;
    bf16_t* O; int ldc;
    __device__ __forceinline__ void operator()(const f32x4 (&acc)[2][2][4][2], const Unit& u, int wr, int wc, int fr, int fq) const {
        const int row0 = u.pm * BM + wr * 64 + fr; const int col0 = u.pn * BM + wc * 32 + 8 * fq;
#pragma unroll
        for (int ai = 0; ai < 2; ++ai)
#pragma unroll
            for (int m = 0; m < 4; ++m) { bf16_t* rowp = O + (size_t)(row0 + ai * HALF + m * 16) * ldc + col0;
#pragma unroll
                for (int bj = 0; bj < 2; ++bj) { f32x4 v0 = acc[ai][bj][m][0], v1 = acc[ai][bj][m][1];
                    if (ACT == 2) {
#pragma unroll
                        for (int q = 0; q < 4; ++q) { const float a = fmaxf(v0[q], 0.f), b = fmaxf(v1[q], 0.f); v0[q] = a * a; v1[q] = b * b; } }
                    u32x4 w; w.x = cvt_pk_bf16(v0[0], v0[1]); w.y = cvt_pk_bf16(v0[2], v0[3]); w.z = cvt_pk_bf16(v1[0], v1[1]); w.w = cvt_pk_bf16(v1[2], v1[3]);
                    *(u32x4*)(rowp + bj * HALF) = w; } }
    }
};
struct EpiGateRes {
    static constexpr bool PERM = false, AFTER_DRAIN = false;
    const float* xa; const float* xb; int split; float* out; const float* mod; int gate_off;
    __device__ __forceinline__ void operator()(const f32x4 (&acc)[2][2][4][2], const Unit& u, int wr, int wc, int fr, int fq) const {
        const int row0 = u.pm * BM + wr * 64 + fr, col0 = u.pn * BM + wc * 32 + 4 * fq;
        const int modi = u.pm < 16 ? 0 : 1 + ((u.pm - 16) >> 3);
        const float* g = mod + (size_t)modi * 6144 + gate_off + col0;
        f32x4 gv[2][2];
#pragma unroll
        for (int bj = 0; bj < 2; ++bj)
#pragma unroll
            for (int n = 0; n < 2; ++n) gv[bj][n] = *(const f32x4*)(g + bj * HALF + n * 16);
#pragma unroll
        for (int ai = 0; ai < 2; ++ai)
#pragma unroll
            for (int m = 0; m < 4; ++m) { const int row = row0 + ai * HALF + m * 16;
                const float* bp = (row < split ? xa + (size_t)row * 1024 : xb + (size_t)(row - split) * 1024) + col0; float* op = out + (size_t)row * 1024 + col0;
#pragma unroll
                for (int bj = 0; bj < 2; ++bj)
#pragma unroll
                    for (int n = 0; n < 2; ++n) { const f32x4 bs = *(const f32x4*)(bp + bj * HALF + n * 16); *(f32x4*)(op + bj * HALF + n * 16) = bs + gv[bj][n] * acc[ai][bj][m][n]; } }
    }
};
template <class Epi, class Sched, bool ALIGN_EPI = false, bool SP2 = false>
__device__ __forceinline__ void gemm_phase(PG8_LAS unsigned char* lds, const Gemm g, const Sched& S, const Epi& E) {
    const int tid = threadIdx.x, wid = __builtin_amdgcn_readfirstlane(tid >> 6), lane = tid & 63, wr = wid >> 2, wc = wid & 3, fr = lane & 15, fq = lane >> 4;
    const int K = g.K, nt = K / BK;
    unsigned voffA[2], voffB[2];
#pragma unroll
    for (int i = 0; i < 2; ++i) { int R, C; stage_rc(tid * 16 + i * 8192, R, C); const int Rb = Epi::PERM ? ((R & ~31) + perm32(R & 31)) : R;
        voffA[i] = (unsigned)(R * K + C) * 2u; voffB[i] = (unsigned)(Rb * K + C) * 2u; }
    const size_t kstep = (size_t)(BK * 2);
    const size_t hstep = (size_t)HALF * K * 2;
    const size_t tstep = 2 * hstep;
    const unsigned ldsw = (unsigned)wid * 1024u;
    const int aoff = lds_byte(wr * 64 + fr, fq * 8), boff = lds_byte(wc * 32 + fr, fq * 8);
#define PG8_SA(b, h) (((b) * 2 + (h)) * HTB)
#define PG8_SB(b, h) ((4 + (b) * 2 + (h)) * HTB)
#define PG8_STAGE(bufoff, gbase, voff) do { _Pragma("unroll") for (int _i = 0; _i < 2; ++_i) \
        __builtin_amdgcn_global_load_lds((const unsigned*)((const char*)(gbase) + (voff)[_i]), (PG8_LAS unsigned*)(lds + (bufoff) + ldsw + _i * 8192), 16, 0, 0); } while (0)
#define PG8_LDA(dst, b, h) do { _Pragma("unroll") for (int m = 0; m < 4; ++m) _Pragma("unroll") for (int k = 0; k < 2; ++k) dst[m][k] = *(const PG8_LAS bf16x8*)(lds + PG8_SA(b, h) + aoff + m * 2048 + k * 1024); } while (0)
#define PG8_LDB(dst, b, h) do { _Pragma("unroll") for (int n = 0; n < 2; ++n) _Pragma("unroll") for (int k = 0; k < 2; ++k) dst[n][k] = *(const PG8_LAS bf16x8*)(lds + PG8_SB(b, h) + boff + n * 2048 + k * 1024); } while (0)
#define PG8_MMA(ai, bj, At, Bt) do { __builtin_amdgcn_s_setprio(1); _Pragma("unroll") for (int m = 0; m < 4; ++m) _Pragma("unroll") for (int n = 0; n < 2; ++n) _Pragma("unroll") for (int k = 0; k < 2; ++k) \
        acc[ai][bj][m][n] = __builtin_amdgcn_mfma_f32_16x16x32_bf16(Bt[n][k], At[m][k], acc[ai][bj][m][n], 0, 0, 0); __builtin_amdgcn_s_setprio(0); } while (0)
#define PG8_WAIT_V(n) asm volatile("s_waitcnt vmcnt(" #n ")" ::: "memory")
#define PG8_WAIT_L(n) asm volatile("s_waitcnt lgkmcnt(" #n ")" ::: "memory")
#define PG8_BAR __builtin_amdgcn_s_barrier()
#define PG8_SCHED __builtin_amdgcn_sched_barrier(0)
    Unit cur, nxt; int ui = 0;
    if (!S.next(0, cur)) return;
    f32x4 acc[2][2][4][2];
#pragma unroll
    for (int a = 0; a < 2; ++a)
#pragma unroll
        for (int b = 0; b < 2; ++b)
#pragma unroll
            for (int m = 0; m < 4; ++m)
#pragma unroll
                for (int n = 0; n < 2; ++n) acc[a][b][m][n] = (f32x4){0.f, 0.f, 0.f, 0.f};
    bf16x8 At[4][2], B0[2][2], B1[2][2];
    const char* cA = (const char*)g.A + (size_t)cur.pm * tstep; const char* cB = (const char*)g.Bt + (size_t)cur.pn * tstep;
    S.a_ready(cur);
    if constexpr (SP2) {
        PG8_STAGE(PG8_SB(0, 0), cB, voffB); PG8_STAGE(PG8_SB(0, 1), cB + hstep, voffB); PG8_STAGE(PG8_SA(0, 0), cA, voffA); PG8_STAGE(PG8_SA(0, 1), cA + hstep, voffA);
        if (wr == 1) PG8_BAR;
        PG8_WAIT_V(2); PG8_BAR;
        PG8_STAGE(PG8_SB(1, 0), cB + kstep, voffB); PG8_STAGE(PG8_SA(1, 0), cA + kstep, voffA); PG8_STAGE(PG8_SB(1, 1), cB + hstep + kstep, voffB);
        PG8_WAIT_V(6); PG8_BAR;
    } else {
        PG8_STAGE(PG8_SB(0, 0), cB, voffB); PG8_STAGE(PG8_SA(0, 0), cA, voffA); PG8_STAGE(PG8_SB(0, 1), cB + hstep, voffB); PG8_STAGE(PG8_SA(0, 1), cA + hstep, voffA);
        if (wr == 1) PG8_BAR;
        PG8_WAIT_V(4); PG8_BAR;
        PG8_STAGE(PG8_SB(1, 0), cB + kstep, voffB); PG8_STAGE(PG8_SA(1, 0), cA + kstep, voffA); PG8_STAGE(PG8_SB(1, 1), cB + hstep + kstep, voffB);
        PG8_WAIT_V(6); PG8_BAR;
    }
    for (;;) {
        const bool has_next = S.next(ui + 1, nxt);
        const char* nA = has_next ? (const char*)g.A + (size_t)nxt.pm * tstep : cA; const char* nB = has_next ? (const char*)g.Bt + (size_t)nxt.pn * tstep : cB;
        for (int t = 0; t < nt; t += 2) {
            const bool last = (t == nt - 2);
            const char* a1 = cA + (size_t)(t + 1) * kstep;
            const char* a2 = last ? nA : cA + (size_t)(t + 2) * kstep; const char* b2 = last ? nB : cB + (size_t)(t + 2) * kstep;
            const char* a3 = a2 + kstep; const char* b3 = b2 + kstep;
            if (last && has_next) S.a_ready(nxt);
            if constexpr (SP2) {
            PG8_LDB(B0, 0, 0); PG8_LDB(B1, 0, 1); PG8_SCHED; PG8_LDA(At, 0, 0); PG8_STAGE(PG8_SA(1, 1), a1 + hstep, voffA);
            PG8_WAIT_V(8); PG8_WAIT_L(0); PG8_BAR; PG8_MMA(0, 0, At, B0); PG8_MMA(0, 1, At, B1); PG8_BAR; PG8_SCHED;
            PG8_LDA(At, 0, 1); PG8_STAGE(PG8_SB(0, 0), b2, voffB); PG8_STAGE(PG8_SB(0, 1), b2 + hstep, voffB); PG8_STAGE(PG8_SA(0, 0), a2, voffA);
            PG8_WAIT_V(8); PG8_WAIT_L(0); PG8_BAR; PG8_MMA(1, 0, At, B0); PG8_MMA(1, 1, At, B1); PG8_BAR; PG8_SCHED;
            PG8_LDB(B0, 1, 0); PG8_LDB(B1, 1, 1); PG8_SCHED; PG8_LDA(At, 1, 0); PG8_STAGE(PG8_SA(0, 1), a2 + hstep, voffA);
            PG8_WAIT_V(8); PG8_WAIT_L(0); PG8_BAR; PG8_MMA(0, 0, At, B0); PG8_MMA(0, 1, At, B1); PG8_BAR; PG8_SCHED;
            PG8_LDA(At, 1, 1); PG8_STAGE(PG8_SB(1, 0), b3, voffB); PG8_STAGE(PG8_SB(1, 1), b3 + hstep, voffB); PG8_STAGE(PG8_SA(1, 0), a3, voffA);
            PG8_WAIT_V(8); PG8_WAIT_L(0); PG8_BAR; PG8_MMA(1, 0, At, B0); PG8_MMA(1, 1, At, B1); PG8_BAR; PG8_SCHED;
            } else {
            PG8_LDB(B0, 0, 0); PG8_SCHED; PG8_LDA(At, 0, 0); PG8_STAGE(PG8_SA(1, 1), a1 + hstep, voffA);
            PG8_WAIT_L(8); PG8_BAR; PG8_WAIT_L(0); PG8_MMA(0, 0, At, B0); PG8_BAR; PG8_SCHED;
            PG8_LDB(B1, 0, 1); PG8_STAGE(PG8_SB(0, 0), b2, voffB);
            PG8_BAR; PG8_WAIT_L(0); PG8_MMA(0, 1, At, B1); PG8_BAR;
            PG8_LDA(At, 0, 1); PG8_STAGE(PG8_SA(0, 0), a2, voffA);
            PG8_BAR; PG8_WAIT_L(0); PG8_MMA(1, 0, At, B0); PG8_BAR; PG8_SCHED;
            PG8_STAGE(PG8_SB(0, 1), b2 + hstep, voffB);
            PG8_WAIT_V(6); PG8_BAR; PG8_MMA(1, 1, At, B1); PG8_BAR;
            PG8_LDB(B0, 1, 0); PG8_SCHED; PG8_LDA(At, 1, 0); PG8_STAGE(PG8_SA(0, 1), a2 + hstep, voffA);
            PG8_WAIT_L(8); PG8_BAR; PG8_WAIT_L(0); PG8_MMA(0, 0, At, B0); PG8_BAR; PG8_SCHED;
            PG8_LDB(B1, 1, 1); PG8_STAGE(PG8_SB(1, 0), b3, voffB);
            PG8_BAR; PG8_WAIT_L(0); PG8_MMA(0, 1, At, B1); PG8_BAR;
            PG8_LDA(At, 1, 1); PG8_STAGE(PG8_SA(1, 0), a3, voffA);
            PG8_BAR; PG8_WAIT_L(0); PG8_MMA(1, 0, At, B0); PG8_BAR; PG8_SCHED;
            PG8_STAGE(PG8_SB(1, 1), b3 + hstep, voffB);
            PG8_WAIT_V(6); PG8_BAR; PG8_MMA(1, 1, At, B1); PG8_BAR;
            }
        }
        if constexpr (ALIGN_EPI) { if (wr == 0) PG8_BAR; }
        if constexpr (!Epi::AFTER_DRAIN) { E(acc, cur, wr, wc, fr, fq); S.done(cur); }
        if (!has_next) break;
#pragma unroll
        for (int a = 0; a < 2; ++a)
#pragma unroll
            for (int b = 0; b < 2; ++b)
#pragma unroll
                for (int m = 0; m < 4; ++m)
#pragma unroll
                    for (int n = 0; n < 2; ++n) acc[a][b][m][n] = (f32x4){0.f, 0.f, 0.f, 0.f};
        cur = nxt; cA = nA; cB = nB; ++ui;
        if constexpr (ALIGN_EPI) { if (wr == 1) PG8_BAR; }
    }
    PG8_WAIT_V(0);
    if constexpr (!ALIGN_EPI) { if (wr == 0) PG8_BAR; }
    PG8_BAR;
    if constexpr (Epi::AFTER_DRAIN) { E.fused(acc, cur, wr, wc, fr, fq, lds, wid, lane); S.done(cur); }
#undef PG8_SA
#undef PG8_SB
#undef PG8_STAGE
#undef PG8_LDA
#undef PG8_LDB
#undef PG8_MMA
#undef PG8_WAIT_V
#undef PG8_WAIT_L
#undef PG8_BAR
#undef PG8_SCHED
}
}
#define XB_TMO      128
#define XB_XCNT(j)  (256  + 64 * (j))
#define XB_XSUB(j)  (1280 + 64 * (j))
#define XB_XGEN(j)  (2304 + 64 * (j))
#define XB_TOP      3328
#define XB_TOPGEN   3392
#define XCD_BAR_WORDS 3456
#define XB_SPIN_CAP (1u << 18)

__device__ __forceinline__ unsigned xb_ld(unsigned* p)              { return __hip_atomic_load(p, __ATOMIC_RELAXED, __HIP_MEMORY_SCOPE_AGENT); }
__device__ __forceinline__ unsigned xb_add(unsigned* p, unsigned v) { return __hip_atomic_fetch_add(p, v, __ATOMIC_RELAXED, __HIP_MEMORY_SCOPE_AGENT); }
__device__ __forceinline__ unsigned xb_xcc_id() { return (unsigned)__builtin_amdgcn_s_getreg((3 << 11) | 20) & 0xFu; }
#define XB_SPIN(cond, bar) do { unsigned _sp = 0; while (cond) { __builtin_amdgcn_s_sleep(1); \
    if ((++_sp & 255u) == 0u) { if (xb_ld(&(bar)[XB_TMO])) break; if (_sp > XB_SPIN_CAP) { atomicAdd(&(bar)[XB_TMO], 1u); break; } } } } while (0)

struct XcdBarrier {
    unsigned* bar; unsigned x;
    volatile LAS unsigned* st;
};

__device__ __forceinline__ XcdBarrier xcd_barrier_post(unsigned* bar, volatile LAS unsigned* st) {
    XcdBarrier b; b.bar = bar; b.x = xb_xcc_id(); b.st = st;
    if (threadIdx.x == 0) (void)xb_add(&bar[XB_XCNT(b.x)], 1u);
    return b;
}
__device__ __forceinline__ void xcd_barrier_complete(unsigned* bar, unsigned x, unsigned& nloc, unsigned& nx) {
    const unsigned G = gridDim.x * gridDim.y * gridDim.z;
    unsigned sum, cnt, mine, sp = 0u;
    for (;;) {
        sum = 0u; cnt = 0u; mine = 0u;
#pragma unroll
        for (unsigned j = 0; j < 16; ++j) { const unsigned c = xb_ld(&bar[XB_XCNT(j)]); sum += c; cnt += (c > 0u) ? 1u : 0u; mine = (j == x) ? c : mine; }
        if (sum == G) break;
        __builtin_amdgcn_s_sleep(1);
        if ((++sp & 255u) == 0u) { if (xb_ld(&bar[XB_TMO])) break; if (sp > XB_SPIN_CAP) { atomicAdd(&bar[XB_TMO], 1u); break; } }
    }
    nloc = mine > 0u ? mine : 1u; nx = cnt > 0u ? cnt : 1u;
}

__device__ __forceinline__ void xcd_barrier(const XcdBarrier& b) {
    asm volatile("s_waitcnt vmcnt(0)" ::: "memory");
    __syncthreads();
    if (threadIdx.x == 0) {
        unsigned* bar = b.bar;
        __builtin_amdgcn_s_waitcnt(0);
        unsigned nloc = b.st[0], nx = b.st[1];
        if (nloc == 0u) { xcd_barrier_complete(bar, b.x, nloc, nx); b.st[0] = nloc; b.st[1] = nx; }
        const unsigned old = xb_add(&bar[XB_XSUB(b.x)], 1u);
        const unsigned gen = old / nloc;
        if (old + 1u == (gen + 1u) * nloc) {
            __builtin_amdgcn_fence(__ATOMIC_RELEASE, "agent");
            asm volatile("s_waitcnt vmcnt(0)" ::: "memory");
            const unsigned og = xb_add(&bar[XB_TOP], 1u);
            const unsigned tg = og / nx;
            if (og + 1u == (tg + 1u) * nx) xb_add(&bar[XB_TOPGEN], 1u);
            else XB_SPIN(xb_ld(&bar[XB_TOPGEN]) == tg, bar);
            __builtin_amdgcn_fence(__ATOMIC_ACQUIRE, "agent");
            xb_add(&bar[XB_XGEN(b.x)], 1u);
            asm volatile("s_waitcnt vmcnt(0)" ::: "memory");
        } else {
            XB_SPIN(xb_ld(&bar[XB_XGEN(b.x)]) == gen, bar);
            __builtin_amdgcn_fence(__ATOMIC_ACQUIRE, "agent");
            asm volatile("s_waitcnt vmcnt(0)" ::: "memory");
        }
    }
    __syncthreads();
}

constexpr int NWAVES = 8;
constexpr int RING_BYTES = 131072, LDSCTL_OFF = RING_BYTES, MISC_OFF = LDSCTL_OFF + 320, LDS_BYTES = 147456;
constexpr size_t CTL_ZERO_BYTES = 1 * MiB;
constexpr int CW_BAR = 4096;
constexpr size_t WS_MODP = WS_MOD + 256 * 1024;
constexpr size_t WS_LW2T = 28 * MiB, WS_LA2T = WS_LW2T + 128 * 1024, WS_LG2T = WS_LW2T + 256 * 1024, WS_LGK2T = WS_LW2T + 384 * 1024;
#define LDS_WAIT() asm volatile("s_waitcnt lgkmcnt(0)" ::: "memory")
#define VM_WAIT() asm volatile("s_waitcnt vmcnt(0)" ::: "memory")
typedef unsigned v4u __attribute__((ext_vector_type(4)));
typedef unsigned u32x4_t __attribute__((ext_vector_type(4)));
__device__ __forceinline__ unsigned pk2(float lo, float hi) { return f2bf(lo) | (f2bf(hi) << 16); }
__device__ __forceinline__ float wave_sum(float v) {
#pragma unroll
    for (int o = 1; o < 64; o <<= 1) v += __shfl_xor(v, o);
    return v;
}

struct SrcPlain { const float* W; int N; __device__ __forceinline__ float operator()(int k, int n) const { return W[(size_t)k * N + n]; } };
struct SrcFold { const float *mu_wag, *w1, *a1, *g1, *gk1;
    __device__ __forceinline__ float operator()(int k, int j) const {
        float v = 0.f;
        if (j < 768) { const int part = j >> 7, c = j & 127, which = part % 3; const bool bpart = part >= 3;
            const float mu = mu_wag[which * D + k], f = bpart ? mu : 1.f - mu; float w;
            if (which == 0) w = w1[((size_t)(c >> 6) * D + k) * 64 + (c & 63)];
            else if (which == 1) w = a1[((size_t)(c >> 6) * D + k) * 64 + (c & 63)];
            else w = g1[(size_t)k * 128 + c];
            v = f * w;
        } else if (j < 800) { const int c = j - 768; v = gk1[((size_t)(c >> 4) * D + k) * 16 + (c & 15)]; }
        return v; } };
template <class Src> __device__ __forceinline__ void p0_transpose_item(const Src& src, int K, int nblk, bf16_t* WT, int row_off, LAS float* scr, int item, int lane) {
    const int kb = item / nblk, nb = item % nblk, k0 = 64 * kb, n0 = 32 * nb;
#pragma unroll 8
    for (int i = 0; i < 32; ++i) { const int kk = 2 * i + (lane >> 5); scr[kk * 33 + (lane & 31)] = src(k0 + kk, n0 + (lane & 31)); }
    LDS_WAIT(); asm volatile("" ::: "memory");
    const int c = lane & 7;
#pragma unroll
    for (int j = 0; j < 4; ++j) { const int n = (lane >> 3) + 8 * j; const LAS float* s = scr + (8 * c) * 33 + n;
        v4u o; o.x = pk2(s[0 * 33], s[1 * 33]); o.y = pk2(s[2 * 33], s[3 * 33]); o.z = pk2(s[4 * 33], s[5 * 33]); o.w = pk2(s[6 * 33], s[7 * 33]);
        *(v4u*)(WT + (size_t)(row_off + n0 + n) * K + k0 + 8 * c) = o; }
    LDS_WAIT(); asm volatile("" ::: "memory");
}
__device__ __forceinline__ void p0_mod_task(const float* c, const float* c_ctx, const float* ada_w, float* MODP, LAS float* scr, int task, int lane) {
    const int cg = task >> 2, ks = task & 3, col = cg * 64 + lane, k0 = ks * 256;
    for (int e = lane; e < 5 * 256; e += 64) { const int b = e >> 8, kk = e & 255; const float x = (b == 0 ? c_ctx : c + (size_t)(b - 1) * D)[k0 + kk]; scr[kk * 8 + b] = x * sigmoidf_(x); }
    LDS_WAIT(); asm volatile("" ::: "memory");
    float a0 = 0.f, a1 = 0.f, a2 = 0.f, a3 = 0.f, a4 = 0.f;
    const float* wp = ada_w + (size_t)k0 * NMOD + col;
#pragma unroll 8
    for (int kk = 0; kk < 256; ++kk) { const float w = wp[(size_t)kk * NMOD]; const f32x4 t = *(const LAS f32x4*)(scr + kk * 8); const float t4 = scr[kk * 8 + 4];
        a0 += t.x * w; a1 += t.y * w; a2 += t.z * w; a3 += t.w * w; a4 += t4 * w; }
    float* o = MODP + (size_t)(ks * 5) * NMOD + col;
    o[0] = a0; o[NMOD] = a1; o[2 * NMOD] = a2; o[3 * NMOD] = a3; o[4 * NMOD] = a4;
    LDS_WAIT(); asm volatile("" ::: "memory");
}
__device__ __forceinline__ void norm_row_bf16(const float* xrow, bf16_t* orow, const LAS float* tg, const LAS float* ts, int lane) {
    const f32x4* xr = (const f32x4*)xrow + lane;
    f32x4 v[4]; float s = 0.f;
#pragma unroll
    for (int j = 0; j < 4; ++j) { v[j] = xr[64 * j]; s += (v[j].x * v[j].x + v[j].y * v[j].y) + (v[j].z * v[j].z + v[j].w * v[j].w); }
    const float rs = rsqrtf(wave_sum(s) * (1.f / D) + 1e-6f);
    unsigned long long* o8 = (unsigned long long*)orow + lane;
#pragma unroll
    for (int j = 0; j < 4; ++j) { const f32x4 g = *(const LAS f32x4*)(tg + 4 * lane + 256 * j), sh = *(const LAS f32x4*)(ts + 4 * lane + 256 * j);
        const f32x4 y = v[j] * rs * g + sh; o8[64 * j] = (unsigned long long)pk2(y.x, y.y) | ((unsigned long long)pk2(y.z, y.w) << 32); }
}


typedef unsigned u32x2 __attribute__((ext_vector_type(2)));
typedef float f32x2_t __attribute__((ext_vector_type(2))); typedef __bf16 bf16x2_t __attribute__((ext_vector_type(2)));
__device__ __forceinline__ unsigned cvtpk(float lo, float hi) { const f32x2_t v = {lo, hi}; const bf16x2_t b = __builtin_convertvector(v, bf16x2_t); return __builtin_bit_cast(unsigned, b); }
__device__ __forceinline__ u32x2 tr_read4(LAS const unsigned char* p) {
    typedef short v4i16_t __attribute__((ext_vector_type(4)));
    return __builtin_bit_cast(u32x2, __builtin_amdgcn_ds_read_tr16_b64_v4i16((LAS v4i16_t*)p));
}
__device__ __forceinline__ bf16x8 frag_lo(u32x2 lo) { const u32x4_t v = {lo.x, lo.y, 0u, 0u}; return __builtin_bit_cast(bf16x8, v); }
__device__ __forceinline__ bf16x8 frag_2(u32x2 lo, u32x2 hi) { const u32x4_t v = {lo.x, lo.y, hi.x, hi.y}; return __builtin_bit_cast(bf16x8, v); }
__device__ __forceinline__ f32x4 bf4_to_f32(u32x2 v) { f32x4 o; o[0] = __builtin_bit_cast(float, v.x << 16); o[1] = __builtin_bit_cast(float, v.x & 0xffff0000u); o[2] = __builtin_bit_cast(float, v.y << 16); o[3] = __builtin_bit_cast(float, v.y & 0xffff0000u); return o; }
__device__ __forceinline__ u32x2 f32_to_bf4(f32x4 v) { u32x2 o; o.x = cvtpk(v[0], v[1]); o.y = cvtpk(v[2], v[3]); return o; }
__device__ __forceinline__ float fast_tanh(float x) { return 1.f - 2.f / (__expf(2.f * x) + 1.f); }
#define MFMA16(a, b, c) __builtin_amdgcn_mfma_f32_16x16x32_bf16((a), (b), (c), 0, 0, 0)
__device__ __forceinline__ float row_prefix(float x, int n) {
#pragma unroll
    for (int dl = 1; dl < 16; dl <<= 1) { const float t = __shfl_up(x, dl, 16); if (n >= dl) x += t; }
    return x;
}
__device__ __forceinline__ float row_last(float x, int lane) { return __shfl(x, lane | 15); }
__device__ __forceinline__ f32x4 row_mirror4(f32x4 v) { f32x4 o; o[0] = __shfl_xor(v[0], 15); o[1] = __shfl_xor(v[1], 15); o[2] = __shfl_xor(v[2], 15); o[3] = __shfl_xor(v[3], 15); return o; }
__device__ __forceinline__ f32x4 exp4(f32x4 v) { f32x4 o; o[0] = __expf(v[0]); o[1] = __expf(v[1]); o[2] = __expf(v[2]); o[3] = __expf(v[3]); return o; }

constexpr int LORA_RS = 848;
constexpr int TS = 144;
struct NbPtr { const bf16_t *p0, *p1, *p2, *p3; float w0, w1, w2, w3; };
__device__ __forceinline__ NbPtr nb_ptrs(const bf16_t* proj, int m) {
    const Tok k = tok_of(m); const Nb nb = shift_nb(k); NbPtr r; const bf16_t* own = proj + (size_t)m * N1;
    r.p0 = nb.n0 >= 0 ? proj + (size_t)nb.n0 * N1 : own; r.w0 = nb.n0 >= 0 ? nb.wgt : 0.f;
    r.p1 = nb.n1 >= 0 ? proj + (size_t)nb.n1 * N1 : own; r.w1 = nb.n1 >= 0 ? nb.wgt : 0.f;
    r.p2 = nb.n2 >= 0 ? proj + (size_t)nb.n2 * N1 : own; r.w2 = nb.n2 >= 0 ? nb.wgt : 0.f;
    r.p3 = nb.n3 >= 0 ? proj + (size_t)nb.n3 * N1 : own; r.w3 = nb.n3 >= 0 ? nb.wgt : 0.f;
    return r;
}
__device__ __forceinline__ void stageA_lora(int g, const bf16_t* proj, LAS unsigned char* lora, int tid) {
    const int tau = tid >> 5, c5 = tid & 31, m = g * 16 + tau; const bool sample = m >= M_P;
    const NbPtr P = nb_ptrs(proj, m);
    const bf16_t* row = proj + (size_t)m * N1 + LA + c5;
    const bf16_t *q0 = P.p0 + LA + 384 + c5, *q1 = P.p1 + LA + 384 + c5, *q2 = P.p2 + LA + 384 + c5, *q3 = P.p3 + LA + 384 + c5;
    LAS bf16_t* out = (LAS bf16_t*)(lora + tau * LORA_RS) + c5;
#pragma unroll
    for (int i = 0; i < 12; ++i) {
        float s = P.w0 * bf2f(q0[32 * i]) + P.w1 * bf2f(q1[32 * i]);
        if (sample) s += P.w2 * bf2f(q2[32 * i]) + P.w3 * bf2f(q3[32 * i]);
        float v = bf2f(row[32 * i]) + s;
        if (i < 4) v = fast_tanh(v); else if (i >= 8) v = sigmoidf_(v);
        out[32 * i] = (bf16_t)f2bf(v); }
    out[384] = row[768];
}
struct StageAW { const float *mu_rkv, *w0, *a0, *k_k, *k_a, *r_k, *gk_b; const bf16_t *w2t, *a2t, *g2t, *gk2t; };

__device__ __forceinline__ f32x4 mm16(f32x4 xt, f32x4 y, f32x4 c) { return MFMA16(frag_lo(f32_to_bf4(xt)), frag_lo(f32_to_bf4(y)), c); }

__device__ __forceinline__ void stageA_unit(int g, int wave, bf16_t* proj, const StageAW& W, LAS const unsigned char* lora, LAS unsigned char* scr, unsigned char* ws, unsigned char* dout, int lane) {
    const int n = lane & 15, q = lane >> 4, m = g * 16 + n, h = wave; const bool sample = m >= M_P;
    const int qq = (lane >> 2) & 3, p4 = lane & 3;
    const f32x4 zero4 = {0.f, 0.f, 0.f, 0.f};
    LAS unsigned char* TB0 = scr; LAS unsigned char* TB1 = scr + 2304; LAS unsigned char* TV = scr + 4608;
    f32x4 rr[4], kx[4], vv[4], kk[4];
    {   const NbPtr P = nb_ptrs(proj, m);
        const int cb = h * 64 + 4 * q;
        const bf16_t* own = proj + (size_t)m * N1 + cb; const bf16_t *q0 = P.p0 + cb, *q1 = P.p1 + cb, *q2 = P.p2 + cb, *q3 = P.p3 + cb;
        const float* mup = W.mu_rkv + cb; const float* kkp = W.k_k + cb;
        float ss = 0.f;
#pragma unroll
        for (int nt = 0; nt < 4; ++nt) {
#pragma unroll
            for (int qn = 0; qn < 3; ++qn) { const int off = qn * RW + 16 * nt;
                const f32x4 x = bf4_to_f32(*(const u32x2*)(own + off));
                f32x4 s = bf4_to_f32(*(const u32x2*)(q0 + off)) * P.w0 + bf4_to_f32(*(const u32x2*)(q1 + off)) * P.w1;
                if (sample) s += bf4_to_f32(*(const u32x2*)(q2 + off)) * P.w2 + bf4_to_f32(*(const u32x2*)(q3 + off)) * P.w3;
                const f32x4 mu = *(const f32x4*)(mup + off); const f32x4 o = x + mu * (s - x);
                if (qn == 0) rr[nt] = o; else if (qn == 1) kx[nt] = o; else vv[nt] = o; }
            kk[nt] = kx[nt] * *(const f32x4*)(kkp + 16 * nt);
            ss += (kk[nt][0] * kk[nt][0] + kk[nt][1] * kk[nt][1]) + (kk[nt][2] * kk[nt][2] + kk[nt][3] * kk[nt][3]);
            asm volatile("" ::: "memory");
        }
        ss += __shfl_xor(ss, 16); ss += __shfl_xor(ss, 32);
        const float rn = rsqrtf(fmaxf(ss, 1e-12f));
#pragma unroll
        for (int nt = 0; nt < 4; ++nt) { kk[nt] = kk[nt] * rn; *(LAS u32x2*)(TV + n * TS + (16 * nt + 4 * q) * 2) = f32_to_bf4(vv[nt]); }
    }
    const size_t uh = (size_t)g * NH + h;
    LDS_WAIT(); asm volatile("" ::: "memory");
#pragma unroll
    for (int vs = 0; vs < 4; ++vs) *(u32x2*)(ws + WS_RV + ((uh * 4 + vs) * 64 + lane) * 8) = tr_read4(TV + (4 * q + qq) * TS + (16 * vs + 4 * p4) * 2);
    float rk_tok = 0.f;
#pragma unroll 1
    for (int d = 0; d < 2; ++d) {
        const size_t ud = uh * 2 + d; const int nd = d ? 15 - n : n;
        if (d) {
#pragma unroll
            for (int nt = 0; nt < 4; ++nt) { rr[nt] = row_mirror4(rr[nt]); kx[nt] = row_mirror4(kx[nt]); kk[nt] = row_mirror4(kk[nt]); } }
        f32x4 lw[4], bb[4], kd[4]; float rks = 0.f;
#pragma unroll
        for (int nt = 0; nt < 4; ++nt) {
            const int chn = h * 64 + 16 * nt;
            f32x4 zw = *(const f32x4*)(W.w0 + d * RW + chn + 4 * q), za = *(const f32x4*)(W.a0 + d * RW + chn + 4 * q);
#pragma unroll
            for (int ks = 0; ks < 2; ++ks) {
                const bf16x8 bw = *(const LAS bf16x8*)(lora + nd * LORA_RS + (d * 64 + 32 * ks + 8 * q) * 2), ba = *(const LAS bf16x8*)(lora + nd * LORA_RS + (128 + d * 64 + 32 * ks + 8 * q) * 2);
                const bf16x8 aw = *(const bf16x8*)(W.w2t + ((size_t)d * RW + chn + n) * 64 + 32 * ks + 8 * q), aa = *(const bf16x8*)(W.a2t + ((size_t)d * RW + chn + n) * 64 + 32 * ks + 8 * q);
                zw = MFMA16(aw, bw, zw); za = MFMA16(aa, ba, za);
            }
            const f32x4 ka4 = *(const f32x4*)(W.k_a + chn + 4 * q), rk4 = *(const f32x4*)(W.r_k + chn + 4 * q);
#pragma unroll
            for (int r = 0; r < 4; ++r) { lw[nt][r] = -0.6065306597126334f * sigmoidf_(zw[r]); const float av = sigmoidf_(za[r]);
                bb[nt][r] = kk[nt][r] * av; kd[nt][r] = kx[nt][r] * (1.f + (av - 1.f) * ka4[r]); rks += rr[nt][r] * kd[nt][r] * rk4[r]; }
            asm volatile("" ::: "memory");
        }
        rks += __shfl_xor(rks, 16); rks += __shfl_xor(rks, 32);
        rk_tok += d ? __shfl_xor(rks, 15) : rks;
        u32x2 pa[4], pr[4], pb[4], pk[4];
#pragma unroll
        for (int nt = 0; nt < 4; ++nt) {
            f32x4 cum, cumC;
#pragma unroll
            for (int r = 0; r < 4; ++r) { cum[r] = row_prefix(lw[nt][r], n); cumC[r] = row_last(cum[r], lane); }
            const f32x4 ex = exp4(cum - lw[nt]), e1 = exp4(cum), ei = exp4(-cum), ec = exp4(cumC - cum);
            pa[nt] = f32_to_bf4(-(kk[nt] * ex)); pr[nt] = f32_to_bf4(rr[nt] * e1); pb[nt] = f32_to_bf4(bb[nt] * ei); pk[nt] = f32_to_bf4(kd[nt] * ei);
            *(LAS u32x2*)(TB0 + n * TS + (16 * nt + 4 * q) * 2) = f32_to_bf4(bb[nt] * ec); *(LAS u32x2*)(TB1 + n * TS + (16 * nt + 4 * q) * 2) = f32_to_bf4(kd[nt] * ec);
            if (n == 0) *(f32x4*)(ws + WS_RGC + (ud * 64 + 16 * nt + 4 * q) * 4) = exp4(cumC);
        }
        bf16x8 fa[2], fr[2], fb[2], fk[2];
#pragma unroll
        for (int ks = 0; ks < 2; ++ks) { fa[ks] = frag_2(pa[2 * ks], pa[2 * ks + 1]); fr[ks] = frag_2(pr[2 * ks], pr[2 * ks + 1]); fb[ks] = frag_2(pb[2 * ks], pb[2 * ks + 1]); fk[ks] = frag_2(pk[2 * ks], pk[2 * ks + 1]);
            *(bf16x8*)(ws + WS_RA + ((ud * 2 + ks) * 64 + lane) * 16) = fa[ks]; *(bf16x8*)(ws + WS_RR + ((ud * 2 + ks) * 64 + lane) * 16) = fr[ks]; }
        f32x4 L = zero4, LT = zero4, LakT = zero4, MrbT = zero4, MrkT = zero4;
#pragma unroll
        for (int ks = 0; ks < 2; ++ks) { L = MFMA16(fa[ks], fb[ks], L); LT = MFMA16(fb[ks], fa[ks], LT); LakT = MFMA16(fk[ks], fa[ks], LakT); MrbT = MFMA16(fb[ks], fr[ks], MrbT); MrkT = MFMA16(fk[ks], fr[ks], MrkT); }
        f32x4 I4;
#pragma unroll
        for (int r = 0; r < 4; ++r) { const int row = 4 * q + r;
            L[r] = n < row ? L[r] : 0.f;
            LT[r] = row < n ? LT[r] : 0.f; LakT[r] = row < n ? LakT[r] : 0.f;
            MrbT[r] = row <= n ? MrbT[r] : 0.f; MrkT[r] = row <= n ? MrkT[r] : 0.f;
            I4[r] = row == n ? 1.f : 0.f; }
        const f32x4 P2 = mm16(LT, L, zero4), P2T = mm16(L, LT, zero4);
        const f32x4 P4 = mm16(P2T, P2, zero4), P4T = mm16(P2, P2T, zero4);
        const f32x4 P8T = mm16(P4, P4T, zero4);
        const f32x4 T1 = I4 + L, T1T = I4 + LT;
        const f32x4 T2 = mm16(P2T, T1, T1), T2T = mm16(T1, P2T, T1T);
        const f32x4 T4 = mm16(P4T, T2, T2), T4T = mm16(T2, P4T, T2T);
        const f32x4 T8T = mm16(T4, P8T, T4T);
        *(bf16x8*)(dout + DO_RSM + ((ud * 2 + 0) * 64 + lane) * 16) = frag_2(f32_to_bf4(MrbT), f32_to_bf4(MrkT));
        *(bf16x8*)(dout + DO_RSM + ((ud * 2 + 1) * 64 + lane) * 16) = frag_2(f32_to_bf4(T8T), f32_to_bf4(LakT));
        LDS_WAIT(); asm volatile("" ::: "memory");
#pragma unroll
        for (int kt = 0; kt < 4; ++kt) { const u32x2 tb = tr_read4(TB0 + (4 * q + qq) * TS + (16 * kt + 4 * p4) * 2), tk = tr_read4(TB1 + (4 * q + qq) * TS + (16 * kt + 4 * p4) * 2);
            *(bf16x8*)(ws + WS_RBK + ((ud * 4 + kt) * 64 + lane) * 16) = frag_2(tb, tk); }
        LDS_WAIT(); asm volatile("" ::: "memory");
    }
    u32x2 gpk[4], bgpk[4];
#pragma unroll
    for (int nt = 0; nt < 4; ++nt) { const int chn = h * 64 + 16 * nt; f32x4 gz = zero4;
#pragma unroll
        for (int ks = 0; ks < 4; ++ks) { const bf16x8 b = *(const LAS bf16x8*)(lora + n * LORA_RS + (256 + 32 * ks + 8 * q) * 2), a = *(const bf16x8*)(W.g2t + ((size_t)chn + n) * 128 + 32 * ks + 8 * q);
            gz = MFMA16(a, b, gz); }
        gpk[nt] = f32_to_bf4(gz); bgpk[nt] = f32_to_bf4(vv[nt] * gz * rk_tok); asm volatile("" ::: "memory"); }
    {   const int hg = wave >> 1, d = wave & 1, nd = d ? 15 - n : n; const size_t md = (size_t)g * 16 + nd;
        const size_t ud = ((size_t)g * GH + hg) * 2 + d, uhg = (size_t)g * GH + hg;
        LAS unsigned char* KT = scr; LAS unsigned char* VT = scr + 2304;
        f32x4 lg[4];
#pragma unroll
        for (int nt = 0; nt < 4; ++nt) { const int cn = hg * 64 + 16 * nt; f32x4 z = *(const f32x4*)(W.gk_b + d * GQK + cn + 4 * q);
            bf16x8 b = *(const LAS bf16x8*)(lora + nd * LORA_RS + (384 + d * 16 + 8 * (q & 1)) * 2); if (q >= 2) b = (bf16x8){0, 0, 0, 0, 0, 0, 0, 0};
            const bf16x8 a = *(const bf16x8*)(W.gk2t + ((size_t)d * GQK + cn + n) * 32 + 8 * q);
            z = MFMA16(a, b, z);
#pragma unroll
            for (int r = 0; r < 4; ++r) lg[nt][r] = log_sigmoidf_(z[r]) * (1.f / 16.f); }
        u32x2 pq[4], pkh[4];
#pragma unroll
        for (int nt = 0; nt < 4; ++nt) {
            const f32x4 qv = bf4_to_f32(*(const u32x2*)(proj + md * N1 + C_GQ + hg * 64 + 16 * nt + 4 * q)), kv = bf4_to_f32(*(const u32x2*)(proj + md * N1 + C_GK + hg * 64 + 16 * nt + 4 * q));
            f32x4 cum, cumC;
#pragma unroll
            for (int r = 0; r < 4; ++r) { cum[r] = row_prefix(lg[nt][r], n); cumC[r] = row_last(cum[r], lane); }
            const f32x4 e1 = exp4(cum), ei = exp4(-cum), ec = exp4(cumC - cum);
            pq[nt] = f32_to_bf4(qv * e1 * 0.125f); pkh[nt] = f32_to_bf4(kv * ei);
            *(LAS u32x2*)(KT + n * TS + (16 * nt + 4 * q) * 2) = f32_to_bf4(kv * ec);
            if (n == 0) *(f32x4*)(ws + WS_GGC + (ud * 64 + 16 * nt + 4 * q) * 4) = exp4(cumC);
        }
        if (d == 0) {
#pragma unroll
            for (int i = 0; i < 4; ++i) { const int row = 4 * i + q; const u32x4_t v = *(const u32x4_t*)(proj + (size_t)(g * 16 + row) * N1 + C_GV + hg * 128 + n * 8);
                *(LAS u32x4_t*)(VT + row * 272 + n * 16) = v; }
        }
        f32x4 at = zero4;
#pragma unroll
        for (int ks = 0; ks < 2; ++ks) { const bf16x8 fq = frag_2(pq[2 * ks], pq[2 * ks + 1]), fkh = frag_2(pkh[2 * ks], pkh[2 * ks + 1]);
            *(bf16x8*)(ws + WS_GQ + ((ud * 2 + ks) * 64 + lane) * 16) = fq;
            at = MFMA16(fkh, fq, at); }
#pragma unroll
        for (int r = 0; r < 4; ++r) at[r] = (4 * q + r <= n) ? at[r] : 0.f;
        *(u32x2*)(ws + WS_GATT + (ud * 64 + lane) * 8) = f32_to_bf4(at);
        LDS_WAIT(); asm volatile("" ::: "memory");
#pragma unroll
        for (int kt = 0; kt < 4; ++kt) *(u32x2*)(ws + WS_GKT + ((ud * 4 + kt) * 64 + lane) * 8) = tr_read4(KT + (4 * q + qq) * TS + (16 * kt + 4 * p4) * 2);
        if (d == 0) {
#pragma unroll
            for (int vs = 0; vs < 8; ++vs) *(u32x2*)(dout + DO_GV + ((uhg * 8 + vs) * 64 + lane) * 8) = tr_read4(VT + (4 * q + qq) * 272 + (16 * vs + 4 * p4) * 2);
        }
        LDS_WAIT(); asm volatile("" ::: "memory");
    }
    __syncthreads();
#pragma unroll
    for (int nt = 0; nt < 4; ++nt) { const int chn = h * 64 + 16 * nt + 4 * q;
        *(u32x2*)(proj + (size_t)m * N1 + C_GATE + chn) = gpk[nt]; *(u32x2*)(dout + DO_BG + ((size_t)m * RW + chn) * 2) = bgpk[nt]; }
}

__device__ __forceinline__ void gla_scan_unit(int unit, const unsigned char* ws, const unsigned char* dout, bf16_t* proj, const float* s_f, const float* s_b, float* os_f, float* os_b, int vs, int lane) {
    const int d = unit & 1, hg = (unit >> 1) & 3, bb = unit >> 3;
    const bool sample = bb >= NB_P; const int b = sample ? bb - NB_P : bb, NC = (sample ? L_S : L_P) / 16, g0 = (sample ? M_P + b * L_S : b * L_P) / 16;
    const int n = lane & 15, q = lane >> 4;
    f32x4 acc[4];
    if (sample) { const float* s0 = (d ? s_b : s_f) + (size_t)(b * GH + hg) * 64 * 128 + 16 * vs + n;
#pragma unroll
        for (int kt = 0; kt < 4; ++kt)
#pragma unroll
            for (int r = 0; r < 4; ++r) acc[kt][r] = s0[(size_t)(16 * kt + 4 * q + r) * 128]; }
    else {
#pragma unroll
        for (int kt = 0; kt < 4; ++kt) acc[kt] = (f32x4){0.f, 0.f, 0.f, 0.f}; }
    const int vlane = d ? (3 - q) * 16 + n : lane;
    for (int c = 0; c < NC; ++c) {
        const int g = g0 + (d ? NC - 1 - c : c);
        const size_t ud = (size_t)(g * 4 + hg) * 2 + d, uh = (size_t)g * 4 + hg;
        const bf16x8 q0 = *(const bf16x8*)(ws + WS_GQ + ((ud * 2 + 0) * 64 + lane) * 16), q1 = *(const bf16x8*)(ws + WS_GQ + ((ud * 2 + 1) * 64 + lane) * 16);
        const u32x2 att = *(const u32x2*)(ws + WS_GATT + (ud * 64 + lane) * 8);
        u32x2 kt4[4];
#pragma unroll
        for (int kt = 0; kt < 4; ++kt) kt4[kt] = *(const u32x2*)(ws + WS_GKT + ((ud * 4 + kt) * 64 + lane) * 8);
        u32x2 vv = *(const u32x2*)(dout + DO_GV + ((uh * 8 + vs) * 64 + vlane) * 8);
        if (d) { const unsigned a = vv.x, bq = vv.y; vv.x = (bq >> 16) | (bq << 16); vv.y = (a >> 16) | (a << 16); }
        f32x4 gc[4];
#pragma unroll
        for (int kt = 0; kt < 4; ++kt) gc[kt] = *(const f32x4*)(ws + WS_GGC + (ud * 64 + 16 * kt + 4 * q) * 4);
        u32x4_t sb0, sb1;
        sb0.x = cvtpk(acc[0][0], acc[0][1]); sb0.y = cvtpk(acc[0][2], acc[0][3]); sb0.z = cvtpk(acc[1][0], acc[1][1]); sb0.w = cvtpk(acc[1][2], acc[1][3]);
        sb1.x = cvtpk(acc[2][0], acc[2][1]); sb1.y = cvtpk(acc[2][2], acc[2][3]); sb1.z = cvtpk(acc[3][0], acc[3][1]); sb1.w = cvtpk(acc[3][2], acc[3][3]);
        const bf16x8 vb = frag_lo(vv);
        f32x4 o = {0.f, 0.f, 0.f, 0.f};
        o = __builtin_amdgcn_mfma_f32_16x16x32_bf16(q0, __builtin_bit_cast(bf16x8, sb0), o, 0, 0, 0);
        o = __builtin_amdgcn_mfma_f32_16x16x32_bf16(q1, __builtin_bit_cast(bf16x8, sb1), o, 0, 0, 0);
        o = __builtin_amdgcn_mfma_f32_16x16x32_bf16(frag_lo(att), vb, o, 0, 0, 0);
#pragma unroll
        for (int kt = 0; kt < 4; ++kt) { acc[kt] = acc[kt] * gc[kt]; acc[kt] = __builtin_amdgcn_mfma_f32_16x16x32_bf16(frag_lo(kt4[kt]), vb, acc[kt], 0, 0, 0); }
#pragma unroll
        for (int r = 0; r < 4; ++r) { const int tau = 4 * q + r; const size_t m = (size_t)g * 16 + (d ? 15 - tau : tau);
            proj[m * N1 + 1024 + d * 512 + hg * 128 + 16 * vs + n] = (bf16_t)f2bf(o[r]); }
    }
    if (!sample) { float* os = (d ? os_b : os_f) + (size_t)(b * GH + hg) * 64 * 128 + 16 * vs + n;
#pragma unroll
        for (int kt = 0; kt < 4; ++kt)
#pragma unroll
            for (int r = 0; r < 4; ++r) os[(size_t)(16 * kt + 4 * q + r) * 128] = acc[kt][r]; }
}


struct RFrag { bf16x8 ra0, ra1, rr0, rr1, sm0; u32x4_t sm1; bf16x8 bk0, bk1, bk2, bk3; u32x2 vv; f32x4 gc0, gc1, gc2, gc3; };
__device__ __forceinline__ RFrag rwkv_load(const unsigned char* ws, const unsigned char* dout, size_t ud, size_t uh, int vs, int lane, int vlane, int q) {
    RFrag f;
    f.ra0 = *(const bf16x8*)(ws + WS_RA + ((ud * 2 + 0) * 64 + lane) * 16); f.ra1 = *(const bf16x8*)(ws + WS_RA + ((ud * 2 + 1) * 64 + lane) * 16);
    f.rr0 = *(const bf16x8*)(ws + WS_RR + ((ud * 2 + 0) * 64 + lane) * 16); f.rr1 = *(const bf16x8*)(ws + WS_RR + ((ud * 2 + 1) * 64 + lane) * 16);
    f.sm0 = *(const bf16x8*)(dout + DO_RSM + ((ud * 2 + 0) * 64 + lane) * 16); f.sm1 = *(const u32x4_t*)(dout + DO_RSM + ((ud * 2 + 1) * 64 + lane) * 16);
    f.bk0 = *(const bf16x8*)(ws + WS_RBK + ((ud * 4 + 0) * 64 + lane) * 16); f.bk1 = *(const bf16x8*)(ws + WS_RBK + ((ud * 4 + 1) * 64 + lane) * 16);
    f.bk2 = *(const bf16x8*)(ws + WS_RBK + ((ud * 4 + 2) * 64 + lane) * 16); f.bk3 = *(const bf16x8*)(ws + WS_RBK + ((ud * 4 + 3) * 64 + lane) * 16);
    f.vv = *(const u32x2*)(ws + WS_RV + ((uh * 4 + vs) * 64 + vlane) * 8);
    f.gc0 = *(const f32x4*)(ws + WS_RGC + (ud * 64 + 0 + 4 * q) * 4); f.gc1 = *(const f32x4*)(ws + WS_RGC + (ud * 64 + 16 + 4 * q) * 4);
    f.gc2 = *(const f32x4*)(ws + WS_RGC + (ud * 64 + 32 + 4 * q) * 4); f.gc3 = *(const f32x4*)(ws + WS_RGC + (ud * 64 + 48 + 4 * q) * 4);
    return f;
}
__device__ __forceinline__ void rwkv_scan_unit(int unit, const unsigned char* ws, const unsigned char* dout, bf16_t* proj, const float* s_f, const float* s_b, float* os_f, float* os_b, int vs, int lane) {
    const int d = unit & 1, h = (unit >> 1) & 7, bb = unit >> 4;
    const bool sample = bb >= NB_P; const int b = sample ? bb - NB_P : bb, NC = (sample ? L_S : L_P) / 16, g0 = (sample ? M_P + b * L_S : b * L_P) / 16;
    const int n = lane & 15, q = lane >> 4; const int vlane = d ? (3 - q) * 16 + n : lane;
    const f32x4 zero4 = {0.f, 0.f, 0.f, 0.f};
    f32x4 acc[4];
    if (sample) { const float* s0 = (d ? s_b : s_f) + ((size_t)(b * NH + h) * 64 + 16 * vs + n) * 64 + 4 * q;
#pragma unroll
        for (int kt = 0; kt < 4; ++kt) acc[kt] = *(const f32x4*)(s0 + 16 * kt); }
    else {
#pragma unroll
        for (int kt = 0; kt < 4; ++kt) acc[kt] = zero4; }
    RFrag cur = rwkv_load(ws, dout, ((size_t)(g0 + (d ? NC - 1 : 0)) * NH + h) * 2 + d, (size_t)(g0 + (d ? NC - 1 : 0)) * NH + h, vs, lane, vlane, q);
    for (int c = 0; c < NC; ++c) {
        const int g = g0 + (d ? NC - 1 - c : c);
        const int c2 = c + 1 < NC ? c + 1 : c; const int g2 = g0 + (d ? NC - 1 - c2 : c2);
        const RFrag nxt = rwkv_load(ws, dout, ((size_t)g2 * NH + h) * 2 + d, (size_t)g2 * NH + h, vs, lane, vlane, q);
        u32x2 vv = cur.vv; if (d) { const unsigned a0 = vv.x, a1 = vv.y; vv.x = (a1 >> 16) | (a1 << 16); vv.y = (a0 >> 16) | (a0 << 16); }
        u32x4_t sb0, sb1;
        sb0.x = cvtpk(acc[0][0], acc[0][1]); sb0.y = cvtpk(acc[0][2], acc[0][3]); sb0.z = cvtpk(acc[1][0], acc[1][1]); sb0.w = cvtpk(acc[1][2], acc[1][3]);
        sb1.x = cvtpk(acc[2][0], acc[2][1]); sb1.y = cvtpk(acc[2][2], acc[2][3]); sb1.z = cvtpk(acc[3][0], acc[3][1]); sb1.w = cvtpk(acc[3][2], acc[3][3]);
        const bf16x8 s0f = __builtin_bit_cast(bf16x8, sb0), s1f = __builtin_bit_cast(bf16x8, sb1), vlo = frag_lo(vv);
        const u32x2 tlo = {cur.sm1.x, cur.sm1.y}, lak = {cur.sm1.z, cur.sm1.w};
        f32x4 x = MFMA16(cur.ra0, s0f, zero4); x = MFMA16(cur.ra1, s1f, x); x = MFMA16(frag_lo(lak), vlo, x);
        const f32x4 sa = MFMA16(frag_lo(tlo), frag_lo(f32_to_bf4(x)), zero4);
        const bf16x8 sv = frag_2(f32_to_bf4(sa), vv);
        f32x4 y = MFMA16(cur.rr0, s0f, zero4); y = MFMA16(cur.rr1, s1f, y); y = MFMA16(cur.sm0, sv, y);
        acc[0] = MFMA16(cur.bk0, sv, acc[0] * cur.gc0); acc[1] = MFMA16(cur.bk1, sv, acc[1] * cur.gc1);
        acc[2] = MFMA16(cur.bk2, sv, acc[2] * cur.gc2); acc[3] = MFMA16(cur.bk3, sv, acc[3] * cur.gc3);
#pragma unroll
        for (int r = 0; r < 4; ++r) { const int tau = 4 * q + r; const size_t mm = (size_t)g * 16 + (d ? 15 - tau : tau);
            proj[mm * N1 + d * RW + h * 64 + 16 * vs + n] = (bf16_t)f2bf(y[r]); }
        cur = nxt;
    }
    if (!sample) { float* os = (d ? os_b : os_f) + ((size_t)(b * NH + h) * 64 + 16 * vs + n) * 64 + 4 * q;
#pragma unroll
        for (int kt = 0; kt < 4; ++kt) *(f32x4*)(os + 16 * kt) = acc[kt]; }
}

enum { PH_P0 = 0, PH_NORM1, PH_GEMM1, PH_PREP, PH_SCAN, PH_COMB, PH_GOUT, PH_NORM2, PH_MLP1, PH_MLP2, PH_FINAL, PH_END };
struct Args { const float* in[36]; float* out; unsigned char* ws; int ph_lo, ph_hi, li, pad; };

__global__ void __launch_bounds__(NWAVES * 64, 2) mega_fwd(Args args) {
    extern __shared__ __attribute__((aligned(16))) unsigned char lds_raw[];
    LAS unsigned char* lds = (LAS unsigned char*)lds_raw;
    volatile LAS unsigned* MISC = (volatile LAS unsigned*)(lds + MISC_OFF);
    const int tid = threadIdx.x, lane = tid & 63, wave = __builtin_amdgcn_readfirstlane(tid >> 6);
    const int G = gridDim.x, bx = blockIdx.x; const int vcu = (G % 8 == 0) ? (bx % 8) * (G / 8) + bx / 8 : bx;
    const int gw = vcu * NWAVES + wave, NGW = G * NWAVES;
    unsigned char* ws = args.ws; float* outf = args.out; unsigned char* dout = (unsigned char*)args.out;
    for (int u = tid; u < (LDS_BYTES - LDSCTL_OFF) / 4; u += NWAVES * 64) ((LAS unsigned*)(lds + LDSCTL_OFF))[u] = 0u;
    __syncthreads();
    XcdBarrier bar = xcd_barrier_post((unsigned*)ws + CW_BAR + args.li * XCD_BAR_WORDS, MISC + 8);
    const int lo = args.ph_lo, hi = args.ph_hi;
#define IN(k) (lo <= (k) && (k) < hi)
#define SEAM(k) do { if (IN(k) && IN((k) + 1)) xcd_barrier(bar); } while (0)

    const float* x_prompt = args.in[0]; const float* x_sample = args.in[1];
    bf16_t* WC1T = (bf16_t*)(ws + WS_WC1T); bf16_t* WOT = (bf16_t*)(ws + WS_WOT); bf16_t* W1T = (bf16_t*)(ws + WS_W1T); bf16_t* W2T = (bf16_t*)(ws + WS_W2T);
    float* MOD = (float*)(ws + WS_MOD); float* MODP = (float*)(ws + WS_MODP);
    bf16_t* XN = (bf16_t*)(ws + WS_XN); bf16_t* MIX = XN; bf16_t* PROJ = (bf16_t*)(ws + WS_PROJ); bf16_t* HB = PROJ; bf16_t* XN2 = (bf16_t*)(ws + WS_R1);
    float* OS_RF = outf + (size_t)M * D; float* OS_RB = OS_RF + 524288; float* OS_GF = OS_RB + 524288; float* OS_GB = OS_GF + 524288;

    if (IN(PH_P0)) {
        LAS float* scr = (LAS float*)(lds + wave * 16384);
        constexpr int I_MOD = 96 * 4, I_IN = 16 * 96, I_FOLD = 16 * 32, I_O = 16 * 32, I_S = 16 * 4 + 32 + 1;
        constexpr int NITEMS = I_MOD + I_IN + I_FOLD + I_O + I_S;
        const SrcPlain s_in{args.in[12], 3072}, s_o{args.in[32], D};
        const SrcFold s_f{args.in[14], args.in[16], args.in[19], args.in[21], args.in[28]};
        for (int it = gw; it < NITEMS; it += NGW) {
            int r = it;
            if (r < I_MOD) { p0_mod_task(args.in[2], args.in[7], args.in[8], MODP, scr, r, lane); continue; } r -= I_MOD;
            if (r < I_IN) { p0_transpose_item(s_in, D, 96, WC1T, 0, scr, r, lane); continue; } r -= I_IN;
            if (r < I_FOLD) { p0_transpose_item(s_f, D, 32, WC1T, LA, scr, r, lane); continue; } r -= I_FOLD;
            if (r < I_O) { p0_transpose_item(s_o, D, 32, WOT, 0, scr, r, lane); continue; } r -= I_O;
            if (r < 64) { const int which = r >> 5, dd = (r >> 4) & 1; const SrcPlain s{args.in[which ? 20 : 17] + (size_t)dd * 64 * RW, RW};
                p0_transpose_item(s, 64, 16, (bf16_t*)(ws + (which ? WS_LA2T : WS_LW2T)) + (size_t)dd * RW * 64, 0, scr, r & 15, lane); continue; } r -= 64;
            if (r < 32) { const SrcPlain s{args.in[22], RW}; p0_transpose_item(s, 128, 16, (bf16_t*)(ws + WS_LG2T), 0, scr, r, lane); continue; }
            { const float* gk2 = args.in[29]; bf16_t* o = (bf16_t*)(ws + WS_LGK2T);
              for (int e = lane; e < 2 * 256 * 32; e += 64) { const int dd = e >> 13, c = (e >> 5) & 255, rk = e & 31; o[e] = rk < 16 ? (bf16_t)f2bf(gk2[((size_t)dd * 16 + rk) * GQK + c]) : (bf16_t)0; } }
        }
    }
    SEAM(PH_P0);
    if (IN(PH_NORM1)) {
        const float* ada_b = args.in[9]; const float* g1n = args.in[10];
        LAS float* TG = (LAS float*)lds; LAS float* TS_ = TG + 5 * 1024;
        for (int e = tid; e < 5 * 1024; e += NWAVES * 64) { const int b = e >> 10, c = e & 1023; float sh = ada_b[c], sc = ada_b[D + c];
#pragma unroll
            for (int ks = 0; ks < 4; ++ks) { sh += MODP[(size_t)(ks * 5 + b) * NMOD + c]; sc += MODP[(size_t)(ks * 5 + b) * NMOD + D + c]; }
            TG[e] = g1n[c] * (1.f + sc); TS_[e] = sh; }
        for (int e = bx * (NWAVES * 64) + tid; e < 5 * NMOD; e += G * NWAVES * 64) { const int b = e / NMOD, c = e % NMOD; float v = ada_b[c];
#pragma unroll
            for (int ks = 0; ks < 4; ++ks) v += MODP[(size_t)(ks * 5 + b) * NMOD + c];
            MOD[e] = v; }
        __syncthreads();
        for (int m = gw; m < M; m += NGW) { const int modi = m < M_P ? 0 : 1 + ((m - M_P) >> 11);
            norm_row_bf16(m < M_P ? x_prompt + (size_t)m * D : x_sample + (size_t)(m - M_P) * D, XN + (size_t)m * D, TG + modi * 1024, TS_ + modi * 1024, lane); }
        __syncthreads();
    }
    SEAM(PH_NORM1);
    if (IN(PH_GEMM1)) {
        pg8::Gemm g{XN, WC1T, M, N1, D}; pg8::StaticOrder S; S.init(M, N1, G, bx);
        pg8::EpiBf16<0> E{PROJ, N1};
        pg8::gemm_phase<pg8::EpiBf16<0>, pg8::StaticOrder, true, true>(lds, g, S, E);
    }
    SEAM(PH_GEMM1);
    if (IN(PH_PREP)) {
        const StageAW W{args.in[13], args.in[15], args.in[18], args.in[23], args.in[24], args.in[25], args.in[30],
                        (const bf16_t*)(ws + WS_LW2T), (const bf16_t*)(ws + WS_LA2T), (const bf16_t*)(ws + WS_LG2T), (const bf16_t*)(ws + WS_LGK2T)};
        for (int g = vcu; g < NGRP; g += G) {
            __syncthreads();
            stageA_lora(g, PROJ, lds, tid);
            __syncthreads();
            stageA_unit(g, wave, PROJ, W, lds, lds + 16384 + wave * 8192, ws, dout, lane);
        }
    }
    SEAM(PH_PREP);
    if (IN(PH_SCAN)) {
        const float *srf = args.in[3], *srb = args.in[4], *sgf = args.in[5], *sgb = args.in[6];
        if (bx < 64) { if (wave < 4) rwkv_scan_unit(256 + bx, ws, dout, PROJ, srf, srb, OS_RF, OS_RB, wave, lane); }
        else if (bx < 96) gla_scan_unit(128 + (bx - 64), ws, dout, PROJ, sgf, sgb, OS_GF, OS_GB, wave, lane);
        else { const int nw = G - 96;
            for (int s = bx - 96; s < 256; s += nw) {
                if (s < 128) rwkv_scan_unit(2 * s + (wave >> 2), ws, dout, PROJ, srf, srb, OS_RF, OS_RB, wave & 3, lane);
                else gla_scan_unit(s - 128, ws, dout, PROJ, sgf, sgb, OS_GF, OS_GB, wave, lane); } }
    }
    SEAM(PH_SCAN);
    if (IN(PH_COMB)) {
        const float* lnx_g = args.in[26]; const float* lnx_b = args.in[27]; const float* gla_g = args.in[31];
        const f32x4 lg0 = *(const f32x4*)(lnx_g + lane * 8), lg1 = *(const f32x4*)(lnx_g + lane * 8 + 4), lb0 = *(const f32x4*)(lnx_b + lane * 8), lb1 = *(const f32x4*)(lnx_b + lane * 8 + 4);
        const f32x4 gn0 = *(const f32x4*)(gla_g + ((lane * 8) & 127)), gn1 = *(const f32x4*)(gla_g + ((lane * 8) & 127) + 4);
        for (int m = gw; m < M; m += NGW) {
            const bf16_t* row = PROJ + (size_t)m * N1;
            const u32x4_t yf = *(const u32x4_t*)(row + lane * 8), yb = *(const u32x4_t*)(row + RW + lane * 8), of = *(const u32x4_t*)(row + 1024 + lane * 8), ob = *(const u32x4_t*)(row + 1536 + lane * 8);
            const u32x4_t gt = *(const u32x4_t*)(row + C_GATE + lane * 8), gg = *(const u32x4_t*)(row + C_GG + lane * 8), bg = *(const u32x4_t*)(dout + DO_BG + ((size_t)m * RW + lane * 8) * 2);
            f32x4 y0 = bf4_to_f32((u32x2){yf.x, yf.y}) + bf4_to_f32((u32x2){yb.x, yb.y}), y1 = bf4_to_f32((u32x2){yf.z, yf.w}) + bf4_to_f32((u32x2){yb.z, yb.w});
            float s1 = (y0[0] + y0[1]) + (y0[2] + y0[3]) + (y1[0] + y1[1]) + (y1[2] + y1[3]);
            s1 += __shfl_xor(s1, 1); s1 += __shfl_xor(s1, 2); s1 += __shfl_xor(s1, 4);
            const float mu = s1 * (1.f / 64.f); y0 = y0 - mu; y1 = y1 - mu;
            float s2 = (y0[0] * y0[0] + y0[1] * y0[1]) + (y0[2] * y0[2] + y0[3] * y0[3]) + (y1[0] * y1[0] + y1[1] * y1[1]) + (y1[2] * y1[2] + y1[3] * y1[3]);
            s2 += __shfl_xor(s2, 1); s2 += __shfl_xor(s2, 2); s2 += __shfl_xor(s2, 4);
            const float rs = rsqrtf(s2 * (1.f / 64.f) + 64e-5f);
            const f32x4 r0 = (y0 * rs * lg0 + lb0) * bf4_to_f32((u32x2){gt.x, gt.y}) + bf4_to_f32((u32x2){bg.x, bg.y});
            const f32x4 r1 = (y1 * rs * lg1 + lb1) * bf4_to_f32((u32x2){gt.z, gt.w}) + bf4_to_f32((u32x2){bg.z, bg.w});
            const u32x2 w0 = f32_to_bf4(r0), w1 = f32_to_bf4(r1);
            *(u32x4_t*)(MIX + (size_t)m * D + lane * 8) = (u32x4_t){w0.x, w0.y, w1.x, w1.y};
            const f32x4 o0 = bf4_to_f32((u32x2){of.x, of.y}) + bf4_to_f32((u32x2){ob.x, ob.y}), o1 = bf4_to_f32((u32x2){of.z, of.w}) + bf4_to_f32((u32x2){ob.z, ob.w});
            float q2 = (o0[0] * o0[0] + o0[1] * o0[1]) + (o0[2] * o0[2] + o0[3] * o0[3]) + (o1[0] * o1[0] + o1[1] * o1[1]) + (o1[2] * o1[2] + o1[3] * o1[3]);
            q2 += __shfl_xor(q2, 1); q2 += __shfl_xor(q2, 2); q2 += __shfl_xor(q2, 4); q2 += __shfl_xor(q2, 8);
            const float rq = rsqrtf(q2 * (1.f / 128.f) + 1e-5f);
            const f32x4 g0 = bf4_to_f32((u32x2){gg.x, gg.y}), g1 = bf4_to_f32((u32x2){gg.z, gg.w}); f32x4 e0, e1;
#pragma unroll
            for (int j = 0; j < 4; ++j) { e0[j] = o0[j] * rq * gn0[j] * (g0[j] * sigmoidf_(g0[j])); e1[j] = o1[j] * rq * gn1[j] * (g1[j] * sigmoidf_(g1[j])); }
            const u32x2 v0 = f32_to_bf4(e0), v1 = f32_to_bf4(e1);
            *(u32x4_t*)(MIX + (size_t)m * D + RW + lane * 8) = (u32x4_t){v0.x, v0.y, v1.x, v1.y};
        }
    }
    SEAM(PH_COMB);
    if (IN(PH_GOUT)) {
        pg8::Gemm g{MIX, WOT, M, D, D}; pg8::StaticOrder S; S.init(M, D, G, bx);
        pg8::EpiGateRes E{x_prompt, x_sample, M_P, outf, MOD, 2 * D};
        pg8::gemm_phase<pg8::EpiGateRes, pg8::StaticOrder, false, true>(lds, g, S, E);
    }
    SEAM(PH_GOUT);
    if (IN(PH_NORM2)) {
        {   LAS float* scr = (LAS float*)(lds + 40960 + wave * 8704);
            constexpr int I_1 = 16 * 128, I_2 = 64 * 32;
            const SrcPlain s_1{args.in[33], FF}, s_2{args.in[34], D};
            for (int it = gw; it < I_1 + I_2; it += NGW) { if (it < I_1) p0_transpose_item(s_1, D, 128, W1T, 0, scr, it, lane); else p0_transpose_item(s_2, FF, 32, W2T, 0, scr, it - I_1, lane); } }
        const float* g2n = args.in[11];
        LAS float* TG = (LAS float*)lds; LAS float* TS_ = TG + 5 * 1024;
        for (int e = tid; e < 5 * 1024; e += NWAVES * 64) { const int b = e >> 10, c = e & 1023; TG[e] = g2n[c] * (1.f + MOD[(size_t)b * NMOD + 4 * D + c]); TS_[e] = MOD[(size_t)b * NMOD + 3 * D + c]; }
        __syncthreads();
        for (int m = gw; m < M; m += NGW) { const int modi = m < M_P ? 0 : 1 + ((m - M_P) >> 11);
            norm_row_bf16(outf + (size_t)m * D, XN2 + (size_t)m * D, TG + modi * 1024, TS_ + modi * 1024, lane); }
        __syncthreads();
    }
    SEAM(PH_NORM2);
    if (IN(PH_MLP1)) {
        pg8::Gemm g{XN2, W1T, M, FF, D}; pg8::StaticOrder S; S.init(M, FF, G, bx);
        pg8::EpiBf16<2> E{HB, FF};
        pg8::gemm_phase<pg8::EpiBf16<2>, pg8::StaticOrder, true, true>(lds, g, S, E);
    }
    SEAM(PH_MLP1);
    if (IN(PH_MLP2)) {
        pg8::Gemm g{HB, W2T, M, D, FF}; pg8::StaticOrder S; S.init(M, D, G, bx);
        pg8::EpiGateRes E{outf, outf, M, outf, MOD, 5 * D};
        pg8::gemm_phase<pg8::EpiGateRes, pg8::StaticOrder, false, true>(lds, g, S, E);
    }
    SEAM(PH_MLP2);
    if (IN(PH_FINAL)) {
        const float* gf = args.in[35];
        f32x4 gv[4];
#pragma unroll
        for (int j = 0; j < 4; ++j) gv[j] = *((const f32x4*)gf + lane + 64 * j);
        for (int m = gw; m < M; m += NGW) { f32x4* xr = (f32x4*)(outf + (size_t)m * D) + lane; f32x4 v[4]; float s = 0.f;
#pragma unroll
            for (int j = 0; j < 4; ++j) { v[j] = xr[64 * j]; s += (v[j].x * v[j].x + v[j].y * v[j].y) + (v[j].z * v[j].z + v[j].w * v[j].w); }
            const float rs = rsqrtf(wave_sum(s) * (1.f / D) + 1e-6f);
#pragma unroll
            for (int j = 0; j < 4; ++j) xr[64 * j] = v[j] * rs * gv[j]; }
    }
#undef IN
#undef SEAM
}

#ifndef N_LAUNCHES
#define N_LAUNCHES 1
#endif
extern "C" void kernel_launch(void* const* d_in, const int* in_sizes, int n_in, void* d_out, int out_size, void* d_ws, size_t ws_size, hipStream_t stream) {
    static int grid = 0;
    if (grid == 0) {
        int dev = 0, cus = 0;
        if (hipGetDevice(&dev) != hipSuccess || hipDeviceGetAttribute(&cus, hipDeviceAttributeMultiprocessorCount, dev) != hipSuccess) { fprintf(stderr, "kernel_launch: device query failed\n"); grid = -1; return; }
        if (hipFuncSetAttribute((const void*)mega_fwd, hipFuncAttributeMaxDynamicSharedMemorySize, LDS_BYTES) != hipSuccess) { fprintf(stderr, "kernel_launch: hipFuncSetAttribute failed\n"); grid = -1; return; }
        int per_cu = 0;
        if (hipOccupancyMaxActiveBlocksPerMultiprocessor(&per_cu, (const void*)mega_fwd, NWAVES * 64, LDS_BYTES) != hipSuccess || per_cu < 1) fprintf(stderr, "kernel_launch: occupancy query reports %d\n", per_cu);
        (void)hipGetLastError();
        grid = cus;
    }
    if (grid < 0) return;
    (void)hipMemsetAsync(d_ws, 0, CTL_ZERO_BYTES, stream);
    Args a{};
    for (int i = 0; i < 36; ++i) a.in[i] = (const float*)d_in[i];
    a.out = (float*)d_out; a.ws = (unsigned char*)d_ws;
    if (N_LAUNCHES == 1) { a.ph_lo = PH_P0; a.ph_hi = PH_END; a.li = 0; hipLaunchKernelGGL(mega_fwd, dim3(grid), dim3(NWAVES * 64), LDS_BYTES, stream, a); }
    else for (int ph = 0; ph < PH_END; ++ph) { a.ph_lo = ph; a.ph_hi = ph + 1; a.li = 0; hipLaunchKernelGGL(mega_fwd, dim3(grid), dim3(NWAVES * 64), LDS_BYTES, stream, a); }
}
```

```cpp
#include <hip/hip_runtime.h>
#include <stdint.h>
#include <cstdio>

typedef unsigned short bf16_t;
typedef short bf16x8 __attribute__((ext_vector_type(8)));
typedef float f32x4 __attribute__((ext_vector_type(4)));

constexpr int D = 1024, NB_P = 16, L_P = 256, NB_S = 4, L_S = 2048;
constexpr int M_P = NB_P * L_P, M_S = NB_S * L_S, M = M_P + M_S;
constexpr int RW = 512, NH = 8, HD = 64, GH = 4, GKD = 64, GVD = 128, GQK = 256;
constexpr int FF = 4096, N1 = 4096, LA = 3072, NMOD = 6 * D;
constexpr int GRID_W = 64, NGRP = M / 16;
constexpr int C_GQ = 1536, C_GK = 1792, C_GV = 2048, C_GG = 2560, C_GATE = 2048;

constexpr size_t MiB = 1u << 20;
constexpr size_t WS_WC1T = 1 * MiB, WS_WOT = 9 * MiB, WS_W1T = 11 * MiB, WS_W2T = 19 * MiB;
constexpr size_t WS_MOD = 27 * MiB;
constexpr size_t WS_XN = 29 * MiB;
constexpr size_t WS_PROJ = 53 * MiB;
constexpr size_t WS_R1 = 149 * MiB;
constexpr size_t WS_RA = 149 * MiB, WS_RR = 173 * MiB, WS_RBK = 197 * MiB, WS_RGC = 245 * MiB, WS_GGC = 248 * MiB, WS_GATT = 249 * MiB + 512 * 1024;
constexpr size_t WS_GQ = 29 * MiB, WS_GKT = 41 * MiB, WS_RV = 11 * MiB;
constexpr size_t DO_BG = 0, DO_RSM = 12 * MiB, DO_GV = 36 * MiB;

__device__ __forceinline__ unsigned f2bf(float f) { unsigned u = __builtin_bit_cast(unsigned, f); return (u + 0x7fffu + ((u >> 16) & 1u)) >> 16; }
__device__ __forceinline__ float bf2f(bf16_t h) { return __builtin_bit_cast(float, (unsigned)h << 16); }
__device__ __forceinline__ float sigmoidf_(float x) { return 1.f / (1.f + __expf(-x)); }
__device__ __forceinline__ float log_sigmoidf_(float x) { return fminf(x, 0.f) - log1pf(__expf(-fabsf(x))); }

struct Tok { int b, t, L, base, modi; bool sample; };
__device__ __forceinline__ Tok tok_of(int m) {
    Tok k;
    if (m < M_P) { k.b = m / L_P; k.t = m % L_P; k.L = L_P; k.base = k.b * L_P; k.modi = 0; k.sample = false; }
    else { int q = m - M_P; k.b = q / L_S; k.t = q % L_S; k.L = L_S; k.base = M_P + k.b * L_S; k.modi = 1 + k.b; k.sample = true; }
    return k;
}
struct Nb { int n0, n1, n2, n3; float wgt; };
__device__ __forceinline__ Nb shift_nb(const Tok& k) {
    Nb r; r.n0 = r.n1 = r.n2 = r.n3 = -1;
    if (!k.sample) { r.wgt = 0.5f; if (k.t > 0) r.n0 = k.base + k.t - 1; if (k.t < k.L - 1) r.n1 = k.base + k.t + 1; }
    else { r.wgt = 0.25f; const int row = k.t / GRID_W, col = k.t % GRID_W;
        if (row > 0) r.n0 = k.base + k.t - GRID_W; if (row < L_S / GRID_W - 1) r.n1 = k.base + k.t + GRID_W;
        if (col > 0) r.n2 = k.base + k.t - 1; if (col < GRID_W - 1) r.n3 = k.base + k.t + 1; }
    return r;
}

#define LAS __attribute__((address_space(3)))
namespace pg8 {
#define PG8_LAS __attribute__((address_space(3)))
typedef unsigned short bf16_t;
typedef short bf16x8 __attribute__((ext_vector_type(8)));
typedef float f32x4 __attribute__((ext_vector_type(4)));
typedef unsigned u32x4 __attribute__((ext_vector_type(4)));
constexpr int BM = 256, BK = 64, HALF = 128, HTB = HALF * BK * 2  , STAGE_BYTES = 8 * HTB, NXCD = 8, WGM = 8;

__host__ __device__ __forceinline__ int lds_byte(int r, int c) { const int st = (r >> 4) * 2 + (c >> 5), rr = r & 15, cc = c & 31, ob = rr * 64 + cc * 2; return st * 1024 + (ob ^ (((ob >> 9) & 1) << 5)); }
__host__ __device__ __forceinline__ void stage_rc(int b, int& R, int& C) { const int st = b / 1024, sb = b % 1024, swz = sb ^ (((sb >> 9) & 1) << 5); R = (st >> 1) * 16 + swz / 64; C = (st & 1) * 32 + (swz % 64) / 2; }
__host__ __device__ __forceinline__ int perm32(int rho) { const int n = rho >> 4, i = rho & 15; return 8 * (i >> 2) + 4 * n + (i & 3); }

struct Unit { int pm, pn; };
struct Gemm { const bf16_t* A; const bf16_t* Bt; int M, N, K; };

struct StaticOrder {
    int nM, nN, nwg, G, c;
    __host__ __device__ void init(int M, int N, int G_, int c_) { nM = M / BM; nN = N / BM; nwg = nM * nN; G = G_; c = c_; }
    __host__ __device__ bool next(int i, Unit& u) const {
        const long L = (long)i * G + c; if (L >= nwg) return false;
        int wgid = (int)L; { const int q = nwg / NXCD, r = nwg % NXCD, xcd = wgid % NXCD, off = wgid / NXCD; wgid = (xcd < r ? xcd * (q + 1) : r * (q + 1) + (xcd - r) * q) + off; }
        const int nig = WGM * nN, gid = wgid / nig, fm = gid * WGM, gsz = (nM - fm) < WGM ? (nM - fm) : WGM;
        u.pm = fm + ((wgid % nig) % gsz); u.pn = (wgid % nig) / gsz; return true;
    }
    __device__ __forceinline__ void a_ready(const Unit&) const {}
    __device__ __forceinline__ void done(const Unit&) const {}
};

typedef float cvt_f32x2 __attribute__((ext_vector_type(2))); typedef __bf16 cvt_bf16x2 __attribute__((ext_vector_type(2)));
__device__ __forceinline__ unsigned cvt_pk_bf16(float lo, float hi) { const cvt_f32x2 v = {lo, hi}; const cvt_bf16x2 b = __builtin_convertvector(v, cvt_bf16x2); return __builtin_bit_cast(unsigned, b); }
typedef float f32x2 __attribute__((ext_vector_type(2)));
template <int ACT  > struct EpiBf16 {
    static constexpr bool PERM = true, AFTER_DRAIN = false;
    bf16_t* O; int ldc;
    __device__ __forceinline__ void operator()(const f32x4 (&acc)[2][2][4][2], const Unit& u, int wr, int wc, int fr, int fq) const {
        const int row0 = u.pm * BM + wr * 64 + fr; const int col0 = u.pn * BM + wc * 32 + 8 * fq;
#pragma unroll
        for (int ai = 0; ai < 2; ++ai)
#pragma unroll
            for (int m = 0; m < 4; ++m) { bf16_t* rowp = O + (size_t)(row0 + ai * HALF + m * 16) * ldc + col0;
#pragma unroll
                for (int bj = 0; bj < 2; ++bj) { f32x4 v0 = acc[ai][bj][m][0], v1 = acc[ai][bj][m][1];
                    if (ACT == 2) {
#pragma unroll
                        for (int q = 0; q < 4; ++q) { const float a = fmaxf(v0[q], 0.f), b = fmaxf(v1[q], 0.f); v0[q] = a * a; v1[q] = b * b; } }
                    u32x4 w; w.x = cvt_pk_bf16(v0[0], v0[1]); w.y = cvt_pk_bf16(v0[2], v0[3]); w.z = cvt_pk_bf16(v1[0], v1[1]); w.w = cvt_pk_bf16(v1[2], v1[3]);
                    *(u32x4*)(rowp + bj * HALF) = w; } }
    }
};
struct EpiGateRes {
    static constexpr bool PERM = false, AFTER_DRAIN = false;
    const float* xa; const float* xb; int split; float* out; const float* mod; int gate_off;
    __device__ __forceinline__ void operator()(const f32x4 (&acc)[2][2][4][2], const Unit& u, int wr, int wc, int fr, int fq) const {
        const int row0 = u.pm * BM + wr * 64 + fr, col0 = u.pn * BM + wc * 32 + 4 * fq;
        const int modi = u.pm < 16 ? 0 : 1 + ((u.pm - 16) >> 3);
        const float* g = mod + (size_t)modi * 6144 + gate_off + col0;
        f32x4 gv[2][2];
#pragma unroll
        for (int bj = 0; bj < 2; ++bj)
#pragma unroll
            for (int n = 0; n < 2; ++n) gv[bj][n] = *(const f32x4*)(g + bj * HALF + n * 16);
#pragma unroll
        for (int ai = 0; ai < 2; ++ai)
#pragma unroll
            for (int m = 0; m < 4; ++m) { const int row = row0 + ai * HALF + m * 16;
                const float* bp = (row < split ? xa + (size_t)row * 1024 : xb + (size_t)(row - split) * 1024) + col0; float* op = out + (size_t)row * 1024 + col0;
#pragma unroll
                for (int bj = 0; bj < 2; ++bj)
#pragma unroll
                    for (int n = 0; n < 2; ++n) { const f32x4 bs = *(const f32x4*)(bp + bj * HALF + n * 16); *(f32x4*)(op + bj * HALF + n * 16) = bs + gv[bj][n] * acc[ai][bj][m][n]; } }
    }
};
template <class Epi, class Sched, bool ALIGN_EPI = false, bool SP2 = false>
__device__ __forceinline__ void gemm_phase(PG8_LAS unsigned char* lds, const Gemm g, const Sched& S, const Epi& E) {
    const int tid = threadIdx.x, wid = __builtin_amdgcn_readfirstlane(tid >> 6), lane = tid & 63, wr = wid >> 2, wc = wid & 3, fr = lane & 15, fq = lane >> 4;
    const int K = g.K, nt = K / BK;
    unsigned voffA[2], voffB[2];
#pragma unroll
    for (int i = 0; i < 2; ++i) { int R, C; stage_rc(tid * 16 + i * 8192, R, C); const int Rb = Epi::PERM ? ((R & ~31) + perm32(R & 31)) : R;
        voffA[i] = (unsigned)(R * K + C) * 2u; voffB[i] = (unsigned)(Rb * K + C) * 2u; }
    const size_t kstep = (size_t)(BK * 2);
    const size_t hstep = (size_t)HALF * K * 2;
    const size_t tstep = 2 * hstep;
    const unsigned ldsw = (unsigned)wid * 1024u;
    const int aoff = lds_byte(wr * 64 + fr, fq * 8), boff = lds_byte(wc * 32 + fr, fq * 8);
#define PG8_SA(b, h) (((b) * 2 + (h)) * HTB)
#define PG8_SB(b, h) ((4 + (b) * 2 + (h)) * HTB)
#define PG8_STAGE(bufoff, gbase, voff) do { _Pragma("unroll") for (int _i = 0; _i < 2; ++_i) \
        __builtin_amdgcn_global_load_lds((const unsigned*)((const char*)(gbase) + (voff)[_i]), (PG8_LAS unsigned*)(lds + (bufoff) + ldsw + _i * 8192), 16, 0, 0); } while (0)
#define PG8_LDA(dst, b, h) do { _Pragma("unroll") for (int m = 0; m < 4; ++m) _Pragma("unroll") for (int k = 0; k < 2; ++k) dst[m][k] = *(const PG8_LAS bf16x8*)(lds + PG8_SA(b, h) + aoff + m * 2048 + k * 1024); } while (0)
#define PG8_LDB(dst, b, h) do { _Pragma("unroll") for (int n = 0; n < 2; ++n) _Pragma("unroll") for (int k = 0; k < 2; ++k) dst[n][k] = *(const PG8_LAS bf16x8*)(lds + PG8_SB(b, h) + boff + n * 2048 + k * 1024); } while (0)
#define PG8_MMA(ai, bj, At, Bt) do { __builtin_amdgcn_s_setprio(1); _Pragma("unroll") for (int m = 0; m < 4; ++m) _Pragma("unroll") for (int n = 0; n < 2; ++n) _Pragma("unroll") for (int k = 0; k < 2; ++k) \
        acc[ai][bj][m][n] = __builtin_amdgcn_mfma_f32_16x16x32_bf16(Bt[n][k], At[m][k], acc[ai][bj][m][n], 0, 0, 0); __builtin_amdgcn_s_setprio(0); } while (0)
#define PG8_WAIT_V(n) asm volatile("s_waitcnt vmcnt(" #n ")" ::: "memory")
#define PG8_WAIT_L(n) asm volatile("s_waitcnt lgkmcnt(" #n ")" ::: "memory")
#define PG8_BAR __builtin_amdgcn_s_barrier()
#define PG8_SCHED __builtin_amdgcn_sched_barrier(0)
    Unit cur, nxt; int ui = 0;
    if (!S.next(0, cur)) return;
    f32x4 acc[2][2][4][2];
#pragma unroll
    for (int a = 0; a < 2; ++a)
#pragma unroll
        for (int b = 0; b < 2; ++b)
#pragma unroll
            for (int m = 0; m < 4; ++m)
#pragma unroll
                for (int n = 0; n < 2; ++n) acc[a][b][m][n] = (f32x4){0.f, 0.f, 0.f, 0.f};
    bf16x8 At[4][2], B0[2][2], B1[2][2];
    const char* cA = (const char*)g.A + (size_t)cur.pm * tstep; const char* cB = (const char*)g.Bt + (size_t)cur.pn * tstep;
    S.a_ready(cur);
    if constexpr (SP2) {
        PG8_STAGE(PG8_SB(0, 0), cB, voffB); PG8_STAGE(PG8_SB(0, 1), cB + hstep, voffB); PG8_STAGE(PG8_SA(0, 0), cA, voffA); PG8_STAGE(PG8_SA(0, 1), cA + hstep, voffA);
        if (wr == 1) PG8_BAR;
        PG8_WAIT_V(2); PG8_BAR;
        PG8_STAGE(PG8_SB(1, 0), cB + kstep, voffB); PG8_STAGE(PG8_SA(1, 0), cA + kstep, voffA); PG8_STAGE(PG8_SB(1, 1), cB + hstep + kstep, voffB);
        PG8_WAIT_V(6); PG8_BAR;
    } else {
        PG8_STAGE(PG8_SB(0, 0), cB, voffB); PG8_STAGE(PG8_SA(0, 0), cA, voffA); PG8_STAGE(PG8_SB(0, 1), cB + hstep, voffB); PG8_STAGE(PG8_SA(0, 1), cA + hstep, voffA);
        if (wr == 1) PG8_BAR;
        PG8_WAIT_V(4); PG8_BAR;
        PG8_STAGE(PG8_SB(1, 0), cB + kstep, voffB); PG8_STAGE(PG8_SA(1, 0), cA + kstep, voffA); PG8_STAGE(PG8_SB(1, 1), cB + hstep + kstep, voffB);
        PG8_WAIT_V(6); PG8_BAR;
    }
    for (;;) {
        const bool has_next = S.next(ui + 1, nxt);
        const char* nA = has_next ? (const char*)g.A + (size_t)nxt.pm * tstep : cA; const char* nB = has_next ? (const char*)g.Bt + (size_t)nxt.pn * tstep : cB;
        for (int t = 0; t < nt; t += 2) {
            const bool last = (t == nt - 2);
            const char* a1 = cA + (size_t)(t + 1) * kstep;
            const char* a2 = last ? nA : cA + (size_t)(t + 2) * kstep; const char* b2 = last ? nB : cB + (size_t)(t + 2) * kstep;
            const char* a3 = a2 + kstep; const char* b3 = b2 + kstep;
            if (last && has_next) S.a_ready(nxt);
            if constexpr (SP2) {
            PG8_LDB(B0, 0, 0); PG8_LDB(B1, 0, 1); PG8_SCHED; PG8_LDA(At, 0, 0); PG8_STAGE(PG8_SA(1, 1), a1 + hstep, voffA);
            PG8_WAIT_V(8); PG8_WAIT_L(0); PG8_BAR; PG8_MMA(0, 0, At, B0); PG8_MMA(0, 1, At, B1); PG8_BAR; PG8_SCHED;
            PG8_LDA(At, 0, 1); PG8_STAGE(PG8_SB(0, 0), b2, voffB); PG8_STAGE(PG8_SB(0, 1), b2 + hstep, voffB); PG8_STAGE(PG8_SA(0, 0), a2, voffA);
            PG8_WAIT_V(8); PG8_WAIT_L(0); PG8_BAR; PG8_MMA(1, 0, At, B0); PG8_MMA(1, 1, At, B1); PG8_BAR; PG8_SCHED;
            PG8_LDB(B0, 1, 0); PG8_LDB(B1, 1, 1); PG8_SCHED; PG8_LDA(At, 1, 0); PG8_STAGE(PG8_SA(0, 1), a2 + hstep, voffA);
            PG8_WAIT_V(8); PG8_WAIT_L(0); PG8_BAR; PG8_MMA(0, 0, At, B0); PG8_MMA(0, 1, At, B1); PG8_BAR; PG8_SCHED;
            PG8_LDA(At, 1, 1); PG8_STAGE(PG8_SB(1, 0), b3, voffB); PG8_STAGE(PG8_SB(1, 1), b3 + hstep, voffB); PG8_STAGE(PG8_SA(1, 0), a3, voffA);
            PG8_WAIT_V(8); PG8_WAIT_L(0); PG8_BAR; PG8_MMA(1, 0, At, B0); PG8_MMA(1, 1, At, B1); PG8_BAR; PG8_SCHED;
            } else {
            PG8_LDB(B0, 0, 0); PG8_SCHED; PG8_LDA(At, 0, 0); PG8_STAGE(PG8_SA(1, 1), a1 + hstep, voffA);
            PG8_WAIT_L(8); PG8_BAR; PG8_WAIT_L(0); PG8_MMA(0, 0, At, B0); PG8_BAR; PG8_SCHED;
            PG8_LDB(B1, 0, 1); PG8_STAGE(PG8_SB(0, 0), b2, voffB);
            PG8_BAR; PG8_WAIT_L(0); PG8_MMA(0, 1, At, B1); PG8_BAR;
            PG8_LDA(At, 0, 1); PG8_STAGE(PG8_SA(0, 0), a2, voffA);
            PG8_BAR; PG8_WAIT_L(0); PG8_MMA(1, 0, At, B0); PG8_BAR; PG8_SCHED;
            PG8_STAGE(PG8_SB(0, 1), b2 + hstep, voffB);
            PG8_WAIT_V(6); PG8_BAR; PG8_MMA(1, 1, At, B1); PG8_BAR;
            PG8_LDB(B0, 1, 0); PG8_SCHED; PG8_LDA(At, 1, 0); PG8_STAGE(PG8_SA(0, 1), a2 + hstep, voffA);
            PG8_WAIT_L(8); PG8_BAR; PG8_WAIT_L(0); PG8_MMA(0, 0, At, B0); PG8_BAR; PG8_SCHED;
            PG8_LDB(B1, 1, 1); PG8_STAGE(PG8_SB(1, 0), b3, voffB);
            PG8_BAR; PG8_WAIT_L(0); PG8_MMA(0, 1, At, B1); PG8_BAR;
            PG8_LDA(At, 1, 1); PG8_STAGE(PG8_SA(1, 0), a3, voffA);
            PG8_BAR; PG8_WAIT_L(0); PG8_MMA(1, 0, At, B0); PG8_BAR; PG8_SCHED;
            PG8_STAGE(PG8_SB(1, 1), b3 + hstep, voffB);
            PG8_WAIT_V(6); PG8_BAR; PG8_MMA(1, 1, At, B1); PG8_BAR;
            }
        }
        if constexpr (ALIGN_EPI) { if (wr == 0) PG8_BAR; }
        if constexpr (!Epi::AFTER_DRAIN) { E(acc, cur, wr, wc, fr, fq); S.done(cur); }
        if (!has_next) break;
#pragma unroll
        for (int a = 0; a < 2; ++a)
#pragma unroll
            for (int b = 0; b < 2; ++b)
#pragma unroll
                for (int m = 0; m < 4; ++m)
#pragma unroll
                    for (int n = 0; n < 2; ++n) acc[a][b][m][n] = (f32x4){0.f, 0.f, 0.f, 0.f};
        cur = nxt; cA = nA; cB = nB; ++ui;
        if constexpr (ALIGN_EPI) { if (wr == 1) PG8_BAR; }
    }
    PG8_WAIT_V(0);
    if constexpr (!ALIGN_EPI) { if (wr == 0) PG8_BAR; }
    PG8_BAR;
    if constexpr (Epi::AFTER_DRAIN) { E.fused(acc, cur, wr, wc, fr, fq, lds, wid, lane); S.done(cur); }
#undef PG8_SA
#undef PG8_SB
#undef PG8_STAGE
#undef PG8_LDA
#undef PG8_LDB
#undef PG8_MMA
#undef PG8_WAIT_V
#undef PG8_WAIT_L
#undef PG8_BAR
#undef PG8_SCHED
}
}
#define XB_TMO      128
#define XB_XCNT(j)  (256  + 64 * (j))
#define XB_XSUB(j)  (1280 + 64 * (j))
#define XB_XGEN(j)  (2304 + 64 * (j))
#define XB_TOP      3328
#define XB_TOPGEN   3392
#define XCD_BAR_WORDS 3456
#define XB_SPIN_CAP (1u << 18)

__device__ __forceinline__ unsigned xb_ld(unsigned* p)              { return __hip_atomic_load(p, __ATOMIC_RELAXED, __HIP_MEMORY_SCOPE_AGENT); }
__device__ __forceinline__ unsigned xb_add(unsigned* p, unsigned v) { return __hip_atomic_fetch_add(p, v, __ATOMIC_RELAXED, __HIP_MEMORY_SCOPE_AGENT); }
__device__ __forceinline__ unsigned xb_xcc_id() { return (unsigned)__builtin_amdgcn_s_getreg((3 << 11) | 20) & 0xFu; }
#define XB_SPIN(cond, bar) do { unsigned _sp = 0; while (cond) { __builtin_amdgcn_s_sleep(1); \
    if ((++_sp & 255u) == 0u) { if (xb_ld(&(bar)[XB_TMO])) break; if (_sp > XB_SPIN_CAP) { atomicAdd(&(bar)[XB_TMO], 1u); break; } } } } while (0)

struct XcdBarrier {
    unsigned* bar; unsigned x;
    volatile LAS unsigned* st;
};

__device__ __forceinline__ XcdBarrier xcd_barrier_post(unsigned* bar, volatile LAS unsigned* st) {
    XcdBarrier b; b.bar = bar; b.x = xb_xcc_id(); b.st = st;
    if (threadIdx.x == 0) (void)xb_add(&bar[XB_XCNT(b.x)], 1u);
    return b;
}
__device__ __forceinline__ void xcd_barrier_complete(unsigned* bar, unsigned x, unsigned& nloc, unsigned& nx) {
    const unsigned G = gridDim.x * gridDim.y * gridDim.z;
    unsigned sum, cnt, mine, sp = 0u;
    for (;;) {
        sum = 0u; cnt = 0u; mine = 0u;
#pragma unroll
        for (unsigned j = 0; j < 16; ++j) { const unsigned c = xb_ld(&bar[XB_XCNT(j)]); sum += c; cnt += (c > 0u) ? 1u : 0u; mine = (j == x) ? c : mine; }
        if (sum == G) break;
        __builtin_amdgcn_s_sleep(1);
        if ((++sp & 255u) == 0u) { if (xb_ld(&bar[XB_TMO])) break; if (sp > XB_SPIN_CAP) { atomicAdd(&bar[XB_TMO], 1u); break; } }
    }
    nloc = mine > 0u ? mine : 1u; nx = cnt > 0u ? cnt : 1u;
}

__device__ __forceinline__ void xcd_barrier(const XcdBarrier& b) {
    asm volatile("s_waitcnt vmcnt(0)" ::: "memory");
    __syncthreads();
    if (threadIdx.x == 0) {
        unsigned* bar = b.bar;
        __builtin_amdgcn_s_waitcnt(0);
        unsigned nloc = b.st[0], nx = b.st[1];
        if (nloc == 0u) { xcd_barrier_complete(bar, b.x, nloc, nx); b.st[0] = nloc; b.st[1] = nx; }
        const unsigned old = xb_add(&bar[XB_XSUB(b.x)], 1u);
        const unsigned gen = old / nloc;
        if (old + 1u == (gen + 1u) * nloc) {
            __builtin_amdgcn_fence(__ATOMIC_RELEASE, "agent");
            asm volatile("s_waitcnt vmcnt(0)" ::: "memory");
            const unsigned og = xb_add(&bar[XB_TOP], 1u);
            const unsigned tg = og / nx;
            if (og + 1u == (tg + 1u) * nx) xb_add(&bar[XB_TOPGEN], 1u);
            else XB_SPIN(xb_ld(&bar[XB_TOPGEN]) == tg, bar);
            __builtin_amdgcn_fence(__ATOMIC_ACQUIRE, "agent");
            xb_add(&bar[XB_XGEN(b.x)], 1u);
            asm volatile("s_waitcnt vmcnt(0)" ::: "memory");
        } else {
            XB_SPIN(xb_ld(&bar[XB_XGEN(b.x)]) == gen, bar);
            __builtin_amdgcn_fence(__ATOMIC_ACQUIRE, "agent");
            asm volatile("s_waitcnt vmcnt(0)" ::: "memory");
        }
    }
    __syncthreads();
}

constexpr int NWAVES = 8;
constexpr int RING_BYTES = 131072, LDSCTL_OFF = RING_BYTES, MISC_OFF = LDSCTL_OFF + 320, LDS_BYTES = 147456;
constexpr size_t CTL_ZERO_BYTES = 1 * MiB;
constexpr int CW_BAR = 4096;
constexpr size_t WS_MODP = WS_MOD + 256 * 1024;
constexpr size_t WS_LW2T = 28 * MiB, WS_LA2T = WS_LW2T + 128 * 1024, WS_LG2T = WS_LW2T + 256 * 1024, WS_LGK2T = WS_LW2T + 384 * 1024;
#define LDS_WAIT() asm volatile("s_waitcnt lgkmcnt(0)" ::: "memory")
#define VM_WAIT() asm volatile("s_waitcnt vmcnt(0)" ::: "memory")
typedef unsigned v4u __attribute__((ext_vector_type(4)));
typedef unsigned u32x4_t __attribute__((ext_vector_type(4)));
__device__ __forceinline__ unsigned pk2(float lo, float hi) { return f2bf(lo) | (f2bf(hi) << 16); }
__device__ __forceinline__ float wave_sum(float v) {
#pragma unroll
    for (int o = 1; o < 64; o <<= 1) v += __shfl_xor(v, o);
    return v;
}

struct SrcPlain { const float* W; int N; __device__ __forceinline__ float operator()(int k, int n) const { return W[(size_t)k * N + n]; } };
struct SrcFold { const float *mu_wag, *w1, *a1, *g1, *gk1;
    __device__ __forceinline__ float operator()(int k, int j) const {
        float v = 0.f;
        if (j < 768) { const int part = j >> 7, c = j & 127, which = part % 3; const bool bpart = part >= 3;
            const float mu = mu_wag[which * D + k], f = bpart ? mu : 1.f - mu; float w;
            if (which == 0) w = w1[((size_t)(c >> 6) * D + k) * 64 + (c & 63)];
            else if (which == 1) w = a1[((size_t)(c >> 6) * D + k) * 64 + (c & 63)];
            else w = g1[(size_t)k * 128 + c];
            v = f * w;
        } else if (j < 800) { const int c = j - 768; v = gk1[((size_t)(c >> 4) * D + k) * 16 + (c & 15)]; }
        return v; } };
template <class Src> __device__ __forceinline__ void p0_transpose_item(const Src& src, int K, int nblk, bf16_t* WT, int row_off, LAS float* scr, int item, int lane) {
    const int kb = item / nblk, nb = item % nblk, k0 = 64 * kb, n0 = 32 * nb;
#pragma unroll 8
    for (int i = 0; i < 32; ++i) { const int kk = 2 * i + (lane >> 5); scr[kk * 33 + (lane & 31)] = src(k0 + kk, n0 + (lane & 31)); }
    LDS_WAIT(); asm volatile("" ::: "memory");
    const int c = lane & 7;
#pragma unroll
    for (int j = 0; j < 4; ++j) { const int n = (lane >> 3) + 8 * j; const LAS float* s = scr + (8 * c) * 33 + n;
        v4u o; o.x = pk2(s[0 * 33], s[1 * 33]); o.y = pk2(s[2 * 33], s[3 * 33]); o.z = pk2(s[4 * 33], s[5 * 33]); o.w = pk2(s[6 * 33], s[7 * 33]);
        *(v4u*)(WT + (size_t)(row_off + n0 + n) * K + k0 + 8 * c) = o; }
    LDS_WAIT(); asm volatile("" ::: "memory");
}
__device__ __forceinline__ void p0_mod_task(const float* c, const float* c_ctx, const float* ada_w, float* MODP, LAS float* scr, int task, int lane) {
    const int cg = task >> 2, ks = task & 3, col = cg * 64 + lane, k0 = ks * 256;
    for (int e = lane; e < 5 * 256; e += 64) { const int b = e >> 8, kk = e & 255; const float x = (b == 0 ? c_ctx : c + (size_t)(b - 1) * D)[k0 + kk]; scr[kk * 8 + b] = x * sigmoidf_(x); }
    LDS_WAIT(); asm volatile("" ::: "memory");
    float a0 = 0.f, a1 = 0.f, a2 = 0.f, a3 = 0.f, a4 = 0.f;
    const float* wp = ada_w + (size_t)k0 * NMOD + col;
#pragma unroll 8
    for (int kk = 0; kk < 256; ++kk) { const float w = wp[(size_t)kk * NMOD]; const f32x4 t = *(const LAS f32x4*)(scr + kk * 8); const float t4 = scr[kk * 8 + 4];
        a0 += t.x * w; a1 += t.y * w; a2 += t.z * w; a3 += t.w * w; a4 += t4 * w; }
    float* o = MODP + (size_t)(ks * 5) * NMOD + col;
    o[0] = a0; o[NMOD] = a1; o[2 * NMOD] = a2; o[3 * NMOD] = a3; o[4 * NMOD] = a4;
    LDS_WAIT(); asm volatile("" ::: "memory");
}
__device__ __forceinline__ void norm_row_bf16(const float* xrow, bf16_t* orow, const LAS float* tg, const LAS float* ts, int lane) {
    const f32x4* xr = (const f32x4*)xrow + lane;
    f32x4 v[4]; float s = 0.f;
#pragma unroll
    for (int j = 0; j < 4; ++j) { v[j] = xr[64 * j]; s += (v[j].x * v[j].x + v[j].y * v[j].y) + (v[j].z * v[j].z + v[j].w * v[j].w); }
    const float rs = rsqrtf(wave_sum(s) * (1.f / D) + 1e-6f);
    unsigned long long* o8 = (unsigned long long*)orow + lane;
#pragma unroll
    for (int j = 0; j < 4; ++j) { const f32x4 g = *(const LAS f32x4*)(tg + 4 * lane + 256 * j), sh = *(const LAS f32x4*)(ts + 4 * lane + 256 * j);
        const f32x4 y = v[j] * rs * g + sh; o8[64 * j] = (unsigned long long)pk2(y.x, y.y) | ((unsigned long long)pk2(y.z, y.w) << 32); }
}


typedef unsigned u32x2 __attribute__((ext_vector_type(2)));
typedef float f32x2_t __attribute__((ext_vector_type(2))); typedef __bf16 bf16x2_t __attribute__((ext_vector_type(2)));
__device__ __forceinline__ unsigned cvtpk(float lo, float hi) { const f32x2_t v = {lo, hi}; const bf16x2_t b = __builtin_convertvector(v, bf16x2_t); return __builtin_bit_cast(unsigned, b); }
__device__ __forceinline__ u32x2 tr_read4(LAS const unsigned char* p) {
    typedef short v4i16_t __attribute__((ext_vector_type(4)));
    return __builtin_bit_cast(u32x2, __builtin_amdgcn_ds_read_tr16_b64_v4i16((LAS v4i16_t*)p));
}
__device__ __forceinline__ bf16x8 frag_lo(u32x2 lo) { const u32x4_t v = {lo.x, lo.y, 0u, 0u}; return __builtin_bit_cast(bf16x8, v); }
__device__ __forceinline__ bf16x8 frag_2(u32x2 lo, u32x2 hi) { const u32x4_t v = {lo.x, lo.y, hi.x, hi.y}; return __builtin_bit_cast(bf16x8, v); }
__device__ __forceinline__ f32x4 bf4_to_f32(u32x2 v) { f32x4 o; o[0] = __builtin_bit_cast(float, v.x << 16); o[1] = __builtin_bit_cast(float, v.x & 0xffff0000u); o[2] = __builtin_bit_cast(float, v.y << 16); o[3] = __builtin_bit_cast(float, v.y & 0xffff0000u); return o; }
__device__ __forceinline__ u32x2 f32_to_bf4(f32x4 v) { u32x2 o; o.x = cvtpk(v[0], v[1]); o.y = cvtpk(v[2], v[3]); return o; }
__device__ __forceinline__ float fast_tanh(float x) { return 1.f - 2.f / (__expf(2.f * x) + 1.f); }
#define MFMA16(a, b, c) __builtin_amdgcn_mfma_f32_16x16x32_bf16((a), (b), (c), 0, 0, 0)
__device__ __forceinline__ float row_prefix(float x, int n) {
#pragma unroll
    for (int dl = 1; dl < 16; dl <<= 1) { const float t = __shfl_up(x, dl, 16); if (n >= dl) x += t; }
    return x;
}
__device__ __forceinline__ float row_last(float x, int lane) { return __shfl(x, lane | 15); }
__device__ __forceinline__ f32x4 row_mirror4(f32x4 v) { f32x4 o; o[0] = __shfl_xor(v[0], 15); o[1] = __shfl_xor(v[1], 15); o[2] = __shfl_xor(v[2], 15); o[3] = __shfl_xor(v[3], 15); return o; }
__device__ __forceinline__ f32x4 exp4(f32x4 v) { f32x4 o; o[0] = __expf(v[0]); o[1] = __expf(v[1]); o[2] = __expf(v[2]); o[3] = __expf(v[3]); return o; }

constexpr int LORA_RS = 848;
constexpr int TS = 144;
struct NbPtr { const bf16_t *p0, *p1, *p2, *p3; float w0, w1, w2, w3; };
__device__ __forceinline__ NbPtr nb_ptrs(const bf16_t* proj, int m) {
    const Tok k = tok_of(m); const Nb nb = shift_nb(k); NbPtr r; const bf16_t* own = proj + (size_t)m * N1;
    r.p0 = nb.n0 >= 0 ? proj + (size_t)nb.n0 * N1 : own; r.w0 = nb.n0 >= 0 ? nb.wgt : 0.f;
    r.p1 = nb.n1 >= 0 ? proj + (size_t)nb.n1 * N1 : own; r.w1 = nb.n1 >= 0 ? nb.wgt : 0.f;
    r.p2 = nb.n2 >= 0 ? proj + (size_t)nb.n2 * N1 : own; r.w2 = nb.n2 >= 0 ? nb.wgt : 0.f;
    r.p3 = nb.n3 >= 0 ? proj + (size_t)nb.n3 * N1 : own; r.w3 = nb.n3 >= 0 ? nb.wgt : 0.f;
    return r;
}
__device__ __forceinline__ void stageA_lora(int g, const bf16_t* proj, LAS unsigned char* lora, int tid) {
    const int tau = tid >> 5, c5 = tid & 31, m = g * 16 + tau; const bool sample = m >= M_P;
    const NbPtr P = nb_ptrs(proj, m);
    const bf16_t* row = proj + (size_t)m * N1 + LA + c5;
    const bf16_t *q0 = P.p0 + LA + 384 + c5, *q1 = P.p1 + LA + 384 + c5, *q2 = P.p2 + LA + 384 + c5, *q3 = P.p3 + LA + 384 + c5;
    LAS bf16_t* out = (LAS bf16_t*)(lora + tau * LORA_RS) + c5;
#pragma unroll
    for (int i = 0; i < 12; ++i) {
        float s = P.w0 * bf2f(q0[32 * i]) + P.w1 * bf2f(q1[32 * i]);
        if (sample) s += P.w2 * bf2f(q2[32 * i]) + P.w3 * bf2f(q3[32 * i]);
        float v = bf2f(row[32 * i]) + s;
        if (i < 4) v = fast_tanh(v); else if (i >= 8) v = sigmoidf_(v);
        out[32 * i] = (bf16_t)f2bf(v); }
    out[384] = row[768];
}
struct StageAW { const float *mu_rkv, *w0, *a0, *k_k, *k_a, *r_k, *gk_b; const bf16_t *w2t, *a2t, *g2t, *gk2t; };

__device__ __forceinline__ f32x4 mm16(f32x4 xt, f32x4 y, f32x4 c) { return MFMA16(frag_lo(f32_to_bf4(xt)), frag_lo(f32_to_bf4(y)), c); }

constexpr int SCR_A = 13824;
__device__ __forceinline__ void stageA_unit(int g, int wave, bf16_t* proj, const StageAW& W, LAS const unsigned char* lora, LAS unsigned char* scr, unsigned char* ws, unsigned char* dout, int lane, bool do_gate = true) {
    const int n = lane & 15, q = lane >> 4, m = g * 16 + n, h = wave; const bool sample = m >= M_P;
    const int qq = (lane >> 2) & 3, p4 = lane & 3;
    const f32x4 zero4 = {0.f, 0.f, 0.f, 0.f};
    LAS unsigned char* TB0 = scr; LAS unsigned char* TB1 = scr + 2304; LAS unsigned char* TR = scr + 4608; LAS unsigned char* TK = scr + 6912; LAS unsigned char* TKK = scr + 9216; LAS unsigned char* TV = scr + 11520;
    const int tcol = 4 * q * 2;
    {   const NbPtr P = nb_ptrs(proj, m);
        const int cb = h * 64 + 4 * q;
        const bf16_t* own = proj + (size_t)m * N1 + cb; const bf16_t *q0 = P.p0 + cb, *q1 = P.p1 + cb, *q2 = P.p2 + cb, *q3 = P.p3 + cb;
        const float* mup = W.mu_rkv + cb; const float* kkp = W.k_k + cb;
        f32x4 kk[4]; float ss = 0.f;
#pragma unroll
        for (int nt = 0; nt < 4; ++nt) {
            f32x4 o3[3];
#pragma unroll
            for (int qn = 0; qn < 3; ++qn) { const int off = qn * RW + 16 * nt;
                const f32x4 x = bf4_to_f32(*(const u32x2*)(own + off));
                f32x4 s = bf4_to_f32(*(const u32x2*)(q0 + off)) * P.w0 + bf4_to_f32(*(const u32x2*)(q1 + off)) * P.w1;
                if (sample) s += bf4_to_f32(*(const u32x2*)(q2 + off)) * P.w2 + bf4_to_f32(*(const u32x2*)(q3 + off)) * P.w3;
                const f32x4 mu = *(const f32x4*)(mup + off); o3[qn] = x + mu * (s - x); }
            *(LAS u32x2*)(TR + n * TS + 32 * nt + tcol) = f32_to_bf4(o3[0]); *(LAS u32x2*)(TK + n * TS + 32 * nt + tcol) = f32_to_bf4(o3[1]); *(LAS u32x2*)(TV + n * TS + 32 * nt + tcol) = f32_to_bf4(o3[2]);
            kk[nt] = o3[1] * *(const f32x4*)(kkp + 16 * nt);
            ss += (kk[nt][0] * kk[nt][0] + kk[nt][1] * kk[nt][1]) + (kk[nt][2] * kk[nt][2] + kk[nt][3] * kk[nt][3]);
            asm volatile("" ::: "memory");
        }
        ss += __shfl_xor(ss, 16); ss += __shfl_xor(ss, 32);
        const float rn = rsqrtf(fmaxf(ss, 1e-12f));
#pragma unroll
        for (int nt = 0; nt < 4; ++nt) *(LAS u32x2*)(TKK + n * TS + 32 * nt + tcol) = f32_to_bf4(kk[nt] * rn);
    }
    const size_t uh = (size_t)g * NH + h;
    LDS_WAIT(); asm volatile("" ::: "memory");
#pragma unroll
    for (int vs = 0; vs < 4; ++vs) *(u32x2*)(ws + WS_RV + ((uh * 2 + (vs >> 1)) * 64 + lane) * 16 + (vs & 1) * 8) = tr_read4(TV + (4 * q + qq) * TS + (16 * vs + 4 * p4) * 2);
    float rk_tok = 0.f;
#pragma unroll 1
    for (int d = 0; d < 2; ++d) {
        const size_t ud = uh * 2 + d; const int nd = d ? 15 - n : n;
        float rks = 0.f; u32x2 pa[4], pr[4], pb[4], pk[4];
#pragma unroll
        for (int nt = 0; nt < 4; ++nt) {
            const int chn = h * 64 + 16 * nt;
            f32x4 zw = *(const f32x4*)(W.w0 + d * RW + chn + 4 * q), za = *(const f32x4*)(W.a0 + d * RW + chn + 4 * q);
#pragma unroll
            for (int ks = 0; ks < 2; ++ks) {
                const bf16x8 bw = *(const LAS bf16x8*)(lora + nd * LORA_RS + (d * 64 + 32 * ks + 8 * q) * 2), ba = *(const LAS bf16x8*)(lora + nd * LORA_RS + (128 + d * 64 + 32 * ks + 8 * q) * 2);
                const bf16x8 aw = *(const bf16x8*)(W.w2t + ((size_t)d * RW + chn + n) * 64 + 32 * ks + 8 * q), aa = *(const bf16x8*)(W.a2t + ((size_t)d * RW + chn + n) * 64 + 32 * ks + 8 * q);
                zw = MFMA16(aw, bw, zw); za = MFMA16(aa, ba, za);
            }
            const f32x4 rr = bf4_to_f32(*(const LAS u32x2*)(TR + nd * TS + 32 * nt + tcol)), kx = bf4_to_f32(*(const LAS u32x2*)(TK + nd * TS + 32 * nt + tcol)), kk = bf4_to_f32(*(const LAS u32x2*)(TKK + nd * TS + 32 * nt + tcol));
            const f32x4 ka4 = *(const f32x4*)(W.k_a + chn + 4 * q), rk4 = *(const f32x4*)(W.r_k + chn + 4 * q);
            f32x4 lw, bb, kd, cum, cumC;
#pragma unroll
            for (int r = 0; r < 4; ++r) { lw[r] = -0.6065306597126334f * sigmoidf_(zw[r]); const float av = sigmoidf_(za[r]);
                bb[r] = kk[r] * av; kd[r] = kx[r] * (1.f + (av - 1.f) * ka4[r]); rks += rr[r] * kd[r] * rk4[r];
                cum[r] = row_prefix(lw[r], n); cumC[r] = row_last(cum[r], lane); }
            const f32x4 ex = exp4(cum - lw), e1 = exp4(cum), ei = exp4(-cum), ec = exp4(cumC - cum);
            pa[nt] = f32_to_bf4(-(kk * ex)); pr[nt] = f32_to_bf4(rr * e1); pb[nt] = f32_to_bf4(bb * ei); pk[nt] = f32_to_bf4(kd * ei);
            *(LAS u32x2*)(TB0 + n * TS + 32 * nt + tcol) = f32_to_bf4(bb * ec); *(LAS u32x2*)(TB1 + n * TS + 32 * nt + tcol) = f32_to_bf4(kd * ec);
            if (n == 0) *(f32x4*)(ws + WS_RGC + (ud * 64 + 16 * nt + 4 * q) * 4) = exp4(cumC);
            asm volatile("" ::: "memory");
        }
        rks += __shfl_xor(rks, 16); rks += __shfl_xor(rks, 32);
        rk_tok += d ? __shfl_xor(rks, 15) : rks;
        bf16x8 fa[2], fr[2], fb[2], fk[2];
#pragma unroll
        for (int ks = 0; ks < 2; ++ks) { fa[ks] = frag_2(pa[2 * ks], pa[2 * ks + 1]); fr[ks] = frag_2(pr[2 * ks], pr[2 * ks + 1]); fb[ks] = frag_2(pb[2 * ks], pb[2 * ks + 1]); fk[ks] = frag_2(pk[2 * ks], pk[2 * ks + 1]);
            *(bf16x8*)(ws + WS_RA + ((ud * 2 + ks) * 64 + lane) * 16) = fa[ks]; *(bf16x8*)(ws + WS_RR + ((ud * 2 + ks) * 64 + lane) * 16) = fr[ks]; }
        f32x4 L = zero4, LT = zero4, LakT = zero4, MrbT = zero4, MrkT = zero4;
#pragma unroll
        for (int ks = 0; ks < 2; ++ks) { L = MFMA16(fa[ks], fb[ks], L); LT = MFMA16(fb[ks], fa[ks], LT); LakT = MFMA16(fk[ks], fa[ks], LakT); MrbT = MFMA16(fb[ks], fr[ks], MrbT); MrkT = MFMA16(fk[ks], fr[ks], MrkT); }
        f32x4 I4;
#pragma unroll
        for (int r = 0; r < 4; ++r) { const int row = 4 * q + r;
            L[r] = n < row ? L[r] : 0.f;
            LT[r] = row < n ? LT[r] : 0.f; LakT[r] = row < n ? LakT[r] : 0.f;
            MrbT[r] = row <= n ? MrbT[r] : 0.f; MrkT[r] = row <= n ? MrkT[r] : 0.f;
            I4[r] = row == n ? 1.f : 0.f; }
        *(bf16x8*)(dout + DO_RSM + ((ud * 2 + 0) * 64 + lane) * 16) = frag_2(f32_to_bf4(MrbT), f32_to_bf4(MrkT));
        const f32x4 P2 = mm16(LT, L, zero4), P2T = mm16(L, LT, zero4);
        const f32x4 P4 = mm16(P2T, P2, zero4), P4T = mm16(P2, P2T, zero4);
        const f32x4 P8T = mm16(P4, P4T, zero4);
        const f32x4 T1 = I4 + L, T1T = I4 + LT;
        const f32x4 T2 = mm16(P2T, T1, T1), T2T = mm16(T1, P2T, T1T);
        const f32x4 T4 = mm16(P4T, T2, T2), T4T = mm16(T2, P4T, T2T);
        const f32x4 T8T = mm16(T4, P8T, T4T);
        *(bf16x8*)(dout + DO_RSM + ((ud * 2 + 1) * 64 + lane) * 16) = frag_2(f32_to_bf4(T8T), f32_to_bf4(LakT));
        LDS_WAIT(); asm volatile("" ::: "memory");
#pragma unroll
        for (int kt = 0; kt < 4; ++kt) { const u32x2 tb = tr_read4(TB0 + (4 * q + qq) * TS + (16 * kt + 4 * p4) * 2), tk = tr_read4(TB1 + (4 * q + qq) * TS + (16 * kt + 4 * p4) * 2);
            *(bf16x8*)(ws + WS_RBK + ((ud * 4 + kt) * 64 + lane) * 16) = frag_2(tb, tk); }
        LDS_WAIT(); asm volatile("" ::: "memory");
    }
    {   const int hg = wave >> 1, d = wave & 1, nd = d ? 15 - n : n; const size_t md = (size_t)g * 16 + nd;
        const size_t ud = ((size_t)g * GH + hg) * 2 + d, uhg = (size_t)g * GH + hg;
        LAS unsigned char* KT = scr; LAS unsigned char* VT = scr + 2304;
        u32x2 pq[4], pkh[4];
#pragma unroll
        for (int nt = 0; nt < 4; ++nt) { const int cn = hg * 64 + 16 * nt; f32x4 z = *(const f32x4*)(W.gk_b + d * GQK + cn + 4 * q);
            bf16x8 b = *(const LAS bf16x8*)(lora + nd * LORA_RS + (384 + d * 16 + 8 * (q & 1)) * 2); if (q >= 2) b = (bf16x8){0, 0, 0, 0, 0, 0, 0, 0};
            const bf16x8 a = *(const bf16x8*)(W.gk2t + ((size_t)d * GQK + cn + n) * 32 + 8 * q);
            z = MFMA16(a, b, z);
            const f32x4 qv = bf4_to_f32(*(const u32x2*)(proj + md * N1 + C_GQ + cn + 4 * q)), kv = bf4_to_f32(*(const u32x2*)(proj + md * N1 + C_GK + cn + 4 * q));
            f32x4 cum, cumC;
#pragma unroll
            for (int r = 0; r < 4; ++r) { cum[r] = row_prefix(log_sigmoidf_(z[r]) * (1.f / 16.f), n); cumC[r] = row_last(cum[r], lane); }
            const f32x4 e1 = exp4(cum), ei = exp4(-cum), ec = exp4(cumC - cum);
            pq[nt] = f32_to_bf4(qv * e1 * 0.125f); pkh[nt] = f32_to_bf4(kv * ei);
            *(LAS u32x2*)(KT + n * TS + 32 * nt + tcol) = f32_to_bf4(kv * ec);
            if (n == 0) *(f32x4*)(ws + WS_GGC + (ud * 64 + 16 * nt + 4 * q) * 4) = exp4(cumC);
            asm volatile("" ::: "memory");
        }
        if (d == 0) {
#pragma unroll
            for (int i = 0; i < 4; ++i) { const int row = 4 * i + q; const u32x4_t v = *(const u32x4_t*)(proj + (size_t)(g * 16 + row) * N1 + C_GV + hg * 128 + n * 8);
                *(LAS u32x4_t*)(VT + row * 272 + n * 16) = v; }
        }
        f32x4 at = zero4;
#pragma unroll
        for (int ks = 0; ks < 2; ++ks) { const bf16x8 fq = frag_2(pq[2 * ks], pq[2 * ks + 1]), fkh = frag_2(pkh[2 * ks], pkh[2 * ks + 1]);
            *(bf16x8*)(ws + WS_GQ + ((ud * 2 + ks) * 64 + lane) * 16) = fq;
            at = MFMA16(fkh, fq, at); }
#pragma unroll
        for (int r = 0; r < 4; ++r) at[r] = (4 * q + r <= n) ? at[r] : 0.f;
        *(bf16x8*)(ws + WS_GATT + (ud * 64 + lane) * 16) = frag_lo(f32_to_bf4(at));
        LDS_WAIT(); asm volatile("" ::: "memory");
#pragma unroll
        for (int kt = 0; kt < 4; ++kt) *(u32x2*)(ws + WS_GKT + ((ud * 2 + (kt >> 1)) * 64 + lane) * 16 + (kt & 1) * 8) = tr_read4(KT + (4 * q + qq) * TS + (16 * kt + 4 * p4) * 2);
        if (d == 0) {
#pragma unroll
            for (int vs = 0; vs < 8; ++vs) *(u32x2*)(dout + DO_GV + ((uhg * 4 + (vs >> 1)) * 64 + lane) * 16 + (vs & 1) * 8) = tr_read4(VT + (4 * q + qq) * 272 + (16 * vs + 4 * p4) * 2);
        }
        LDS_WAIT(); asm volatile("" ::: "memory");
    }
    u32x2 gpk[4], bgpk[4];
#pragma unroll
    for (int nt = 0; nt < 4; ++nt) { const int chn = h * 64 + 16 * nt; f32x4 gz = zero4;
#pragma unroll
        for (int ks = 0; ks < 4; ++ks) { const bf16x8 b = *(const LAS bf16x8*)(lora + n * LORA_RS + (256 + 32 * ks + 8 * q) * 2), a = *(const bf16x8*)(W.g2t + ((size_t)chn + n) * 128 + 32 * ks + 8 * q);
            gz = MFMA16(a, b, gz); }
        const f32x4 v4 = bf4_to_f32(*(const LAS u32x2*)(TV + n * TS + 32 * nt + tcol));
        gpk[nt] = f32_to_bf4(gz); bgpk[nt] = f32_to_bf4(v4 * gz * rk_tok); asm volatile("" ::: "memory"); }
    __syncthreads();
    if (do_gate)
#pragma unroll
    for (int nt = 0; nt < 4; ++nt) { const int chn = h * 64 + 16 * nt + 4 * q;
        *(u32x2*)(proj + (size_t)m * N1 + C_GATE + chn) = gpk[nt]; *(u32x2*)(dout + DO_BG + ((size_t)m * RW + chn) * 2) = bgpk[nt]; }
}

__device__ __forceinline__ void dma16(const void* gsrc_lane, LAS unsigned char* lds_block) { __builtin_amdgcn_global_load_lds((const unsigned*)gsrc_lane, (LAS unsigned*)lds_block, 16, 0, 0); }
__device__ __forceinline__ void dma4(const void* gsrc_lane, LAS unsigned char* lds_block) { __builtin_amdgcn_global_load_lds((const unsigned*)gsrc_lane, (LAS unsigned*)lds_block, 4, 0, 0); }
#define SCAN_WAIT_V(n) asm volatile("s_waitcnt vmcnt(" #n ")" ::: "memory")
#define SCAN_BAR() do { asm volatile("" ::: "memory"); __builtin_amdgcn_s_barrier(); asm volatile("" ::: "memory"); } while (0)
constexpr int RSLOT = 13 * 1024;
constexpr int GSLOT = 10 * 1024;

template <int D> __device__ __forceinline__ void rwkv_scan_ring(int unit, LAS unsigned char* ring, const unsigned char* ws, const unsigned char* dout, bf16_t* proj, const float* s_f, const float* s_b, float* os_f, float* os_b, int w4, int lane) {
    const int d = unit & 1, h = (unit >> 1) & 7, bb = unit >> 4, vs = w4;
    const bool sample = bb >= NB_P; const int b = sample ? bb - NB_P : bb, NC = (sample ? L_S : L_P) / 16, g0 = (sample ? M_P + b * L_S : b * L_P) / 16;
    const int n = lane & 15, q = lane >> 4; const int vlane = d ? (3 - q) * 16 + n : lane;
    const f32x4 zero4 = {0.f, 0.f, 0.f, 0.f};
    const unsigned char* b0; const unsigned char* b1; const unsigned char* b2; size_t st0, st1, st2; int k0, k1, k2;
    if (w4 == 0)      { b0 = ws + WS_RA;        st0 = 2048; k0 = 0; b1 = dout + DO_RSM;        st1 = 2048; k1 = 4; b2 = ws + WS_RBK + 2048; st2 = 4096; k2 = 8; }
    else if (w4 == 1) { b0 = ws + WS_RA + 1024; st0 = 2048; k0 = 1; b1 = dout + DO_RSM + 1024; st1 = 2048; k1 = 5; b2 = ws + WS_RBK + 3072; st2 = 4096; k2 = 9; }
    else if (w4 == 2) { b0 = ws + WS_RR;        st0 = 2048; k0 = 2; b1 = ws + WS_RBK;          st1 = 4096; k1 = 6; b2 = ws + WS_RV;         st2 = 0;    k2 = 10; }
    else              { b0 = ws + WS_RR + 1024; st0 = 2048; k0 = 3; b1 = ws + WS_RBK + 1024;   st1 = 4096; k1 = 7; b2 = ws + WS_RV + 1024;  st2 = 0;    k2 = 11; }
    f32x4 acc[4];
    if (sample) { const float* s0 = (d ? s_b : s_f) + ((size_t)(b * NH + h) * 64 + 16 * vs + n) * 64 + 4 * q;
#pragma unroll
        for (int kt = 0; kt < 4; ++kt) acc[kt] = *(const f32x4*)(s0 + 16 * kt); }
    else {
#pragma unroll
        for (int kt = 0; kt < 4; ++kt) acc[kt] = zero4; }
    SCAN_WAIT_V(0); SCAN_BAR();
#define RW_ISSUE(step, slot) do { const int s_ = (step) < NC ? (step) : NC - 1; const int g_ = g0 + (d ? NC - 1 - s_ : s_); const size_t ud_ = ((size_t)g_ * NH + h) * 2 + d, uh_ = (size_t)g_ * NH + h; \
        LAS unsigned char* sl_ = ring + (slot) * RSLOT; \
        dma16(b0 + ud_ * st0 + lane * 16, sl_ + k0 * 1024); dma16(b1 + ud_ * st1 + lane * 16, sl_ + k1 * 1024); \
        dma16(b2 + (st2 ? ud_ * st2 : uh_ * 2048) + lane * 16, sl_ + k2 * 1024); dma4(ws + WS_RGC + ud_ * 256 + lane * 4, sl_ + 12 * 1024); } while (0)
    int islot = 0;
#pragma unroll 1
    for (int s = 0; s < D - 1; ++s) { RW_ISSUE(s, islot); islot = islot + 1 == D ? 0 : islot + 1; }
    int cslot = 0;
#pragma unroll 1
    for (int c = 0; c < NC; ++c) {
        if (D == 2) SCAN_WAIT_V(0); else if (D == 3) SCAN_WAIT_V(4); else if (D == 4) SCAN_WAIT_V(8); else if (D == 5) SCAN_WAIT_V(12); else if (D == 6) SCAN_WAIT_V(16); else if (D == 7) SCAN_WAIT_V(20); else SCAN_WAIT_V(24);
        SCAN_BAR();
        RW_ISSUE(c + D - 1, islot); islot = islot + 1 == D ? 0 : islot + 1;
        const LAS unsigned char* sl = ring + cslot * RSLOT; cslot = cslot + 1 == D ? 0 : cslot + 1;
        const bf16x8 ra0 = *(const LAS bf16x8*)(sl + 0 * 1024 + lane * 16), ra1 = *(const LAS bf16x8*)(sl + 1 * 1024 + lane * 16);
        const bf16x8 rr0 = *(const LAS bf16x8*)(sl + 2 * 1024 + lane * 16), rr1 = *(const LAS bf16x8*)(sl + 3 * 1024 + lane * 16);
        const bf16x8 sm0 = *(const LAS bf16x8*)(sl + 4 * 1024 + lane * 16); const u32x4_t sm1 = *(const LAS u32x4_t*)(sl + 5 * 1024 + lane * 16);
        u32x2 vv = *(const LAS u32x2*)(sl + (10 + (vs >> 1)) * 1024 + vlane * 16 + (vs & 1) * 8);
        if (d) { const unsigned a0 = vv.x, a1 = vv.y; vv.x = (a1 >> 16) | (a1 << 16); vv.y = (a0 >> 16) | (a0 << 16); }
        const int g = g0 + (d ? NC - 1 - c : c);
        u32x4_t sb0, sb1;
        sb0.x = cvtpk(acc[0][0], acc[0][1]); sb0.y = cvtpk(acc[0][2], acc[0][3]); sb0.z = cvtpk(acc[1][0], acc[1][1]); sb0.w = cvtpk(acc[1][2], acc[1][3]);
        sb1.x = cvtpk(acc[2][0], acc[2][1]); sb1.y = cvtpk(acc[2][2], acc[2][3]); sb1.z = cvtpk(acc[3][0], acc[3][1]); sb1.w = cvtpk(acc[3][2], acc[3][3]);
        const bf16x8 s0f = __builtin_bit_cast(bf16x8, sb0), s1f = __builtin_bit_cast(bf16x8, sb1), vlo = frag_lo(vv);
        const u32x2 tlo = {sm1.x, sm1.y}, lak = {sm1.z, sm1.w};
        f32x4 x = MFMA16(ra0, s0f, zero4); x = MFMA16(ra1, s1f, x); x = MFMA16(frag_lo(lak), vlo, x);
        const f32x4 sa = MFMA16(frag_lo(tlo), frag_lo(f32_to_bf4(x)), zero4);
        const bf16x8 sv = frag_2(f32_to_bf4(sa), vv);
        f32x4 y = MFMA16(rr0, s0f, zero4); y = MFMA16(rr1, s1f, y); y = MFMA16(sm0, sv, y);
#pragma unroll
        for (int kt = 0; kt < 4; ++kt) { const bf16x8 bk = *(const LAS bf16x8*)(sl + (6 + kt) * 1024 + lane * 16); const f32x4 gc = *(const LAS f32x4*)(sl + 12 * 1024 + (16 * kt + 4 * q) * 4);
            acc[kt] = MFMA16(bk, sv, acc[kt] * gc); }
#pragma unroll
        for (int r = 0; r < 4; ++r) { const int tau = 4 * q + r; const size_t mm = (size_t)g * 16 + (d ? 15 - tau : tau);
            proj[mm * N1 + d * RW + h * 64 + 16 * vs + n] = (bf16_t)f2bf(y[r]); }
    }
#undef RW_ISSUE
    SCAN_WAIT_V(0);
    if (!sample) { float* os = (d ? os_b : os_f) + ((size_t)(b * NH + h) * 64 + 16 * vs + n) * 64 + 4 * q;
#pragma unroll
        for (int kt = 0; kt < 4; ++kt) *(f32x4*)(os + 16 * kt) = acc[kt]; }
}
__device__ __forceinline__ void scan_idle(int nc) { SCAN_WAIT_V(0); SCAN_BAR();
#pragma unroll 1
    for (int c = 0; c < nc; ++c) SCAN_BAR(); }

template <int D> __device__ __forceinline__ void gla_scan_ring(int unit, LAS unsigned char* ring, const unsigned char* ws, const unsigned char* dout, bf16_t* proj, const float* s_f, const float* s_b, float* os_f, float* os_b, int vs, int lane) {
    const int d = unit & 1, hg = (unit >> 1) & 3, bb = unit >> 3;
    const bool sample = bb >= NB_P; const int b = sample ? bb - NB_P : bb, NC = (sample ? L_S : L_P) / 16, g0 = (sample ? M_P + b * L_S : b * L_P) / 16;
    const int n = lane & 15, q = lane >> 4; const int vlane = d ? (3 - q) * 16 + n : lane;
    const f32x4 zero4 = {0.f, 0.f, 0.f, 0.f};
    const unsigned char* b0; size_t st0; bool byuh = false;
    if (vs < 2)       { b0 = ws + WS_GQ + vs * 1024;          st0 = 2048; }
    else if (vs < 4)  { b0 = ws + WS_GKT + (vs - 2) * 1024;   st0 = 2048; }
    else if (vs == 4) { b0 = ws + WS_GATT;                    st0 = 1024; }
    else              { b0 = dout + DO_GV + (vs - 5) * 1024;  st0 = 4096; byuh = true; }
    f32x4 acc[4];
    if (sample) { const float* s0 = (d ? s_b : s_f) + (size_t)(b * GH + hg) * 64 * 128 + 16 * vs + n;
#pragma unroll
        for (int kt = 0; kt < 4; ++kt)
#pragma unroll
            for (int r = 0; r < 4; ++r) acc[kt][r] = s0[(size_t)(16 * kt + 4 * q + r) * 128]; }
    else {
#pragma unroll
        for (int kt = 0; kt < 4; ++kt) acc[kt] = zero4; }
    SCAN_WAIT_V(0); SCAN_BAR();
#define GL_ISSUE(step, slot) do { const int s_ = (step) < NC ? (step) : NC - 1; const int g_ = g0 + (d ? NC - 1 - s_ : s_); const size_t ud_ = ((size_t)g_ * GH + hg) * 2 + d, uh_ = (size_t)g_ * GH + hg; \
        LAS unsigned char* sl_ = ring + (slot) * GSLOT; \
        dma16(b0 + (byuh ? uh_ : ud_) * st0 + lane * 16, sl_ + vs * 1024); \
        if (vs == 0) dma16(dout + DO_GV + uh_ * 4096 + 3072 + lane * 16, sl_ + 8 * 1024); \
        else if (vs == 1) dma4(ws + WS_GGC + ud_ * 256 + lane * 4, sl_ + 9 * 1024); \
        else dma16(b0 + (byuh ? uh_ : ud_) * st0 + lane * 16, sl_ + vs * 1024); } while (0)
    int islot = 0;
#pragma unroll 1
    for (int s = 0; s < D - 1; ++s) { GL_ISSUE(s, islot); islot = islot + 1 == D ? 0 : islot + 1; }
    int cslot = 0;
#pragma unroll 1
    for (int c = 0; c < NC; ++c) {
        if (D == 2) SCAN_WAIT_V(0); else if (D == 3) SCAN_WAIT_V(2); else if (D == 4) SCAN_WAIT_V(4); else if (D == 5) SCAN_WAIT_V(6); else if (D == 6) SCAN_WAIT_V(8); else if (D == 7) SCAN_WAIT_V(10); else SCAN_WAIT_V(12);
        SCAN_BAR();
        GL_ISSUE(c + D - 1, islot); islot = islot + 1 == D ? 0 : islot + 1;
        const LAS unsigned char* sl = ring + cslot * GSLOT; cslot = cslot + 1 == D ? 0 : cslot + 1;
        const bf16x8 q0 = *(const LAS bf16x8*)(sl + 0 * 1024 + lane * 16), q1 = *(const LAS bf16x8*)(sl + 1 * 1024 + lane * 16), att = *(const LAS bf16x8*)(sl + 4 * 1024 + lane * 16);
        u32x2 vv = *(const LAS u32x2*)(sl + (5 + (vs >> 1)) * 1024 + vlane * 16 + (vs & 1) * 8);
        if (d) { const unsigned a0 = vv.x, a1 = vv.y; vv.x = (a1 >> 16) | (a1 << 16); vv.y = (a0 >> 16) | (a0 << 16); }
        const int g = g0 + (d ? NC - 1 - c : c);
        u32x4_t sb0, sb1;
        sb0.x = cvtpk(acc[0][0], acc[0][1]); sb0.y = cvtpk(acc[0][2], acc[0][3]); sb0.z = cvtpk(acc[1][0], acc[1][1]); sb0.w = cvtpk(acc[1][2], acc[1][3]);
        sb1.x = cvtpk(acc[2][0], acc[2][1]); sb1.y = cvtpk(acc[2][2], acc[2][3]); sb1.z = cvtpk(acc[3][0], acc[3][1]); sb1.w = cvtpk(acc[3][2], acc[3][3]);
        const bf16x8 vb = frag_lo(vv);
        f32x4 o = MFMA16(q0, __builtin_bit_cast(bf16x8, sb0), zero4); o = MFMA16(q1, __builtin_bit_cast(bf16x8, sb1), o); o = MFMA16(att, vb, o);
#pragma unroll
        for (int kt = 0; kt < 4; ++kt) { const u32x2 k4 = *(const LAS u32x2*)(sl + (2 + (kt >> 1)) * 1024 + lane * 16 + (kt & 1) * 8); const f32x4 gc = *(const LAS f32x4*)(sl + 9 * 1024 + (16 * kt + 4 * q) * 4);
            acc[kt] = MFMA16(frag_lo(k4), vb, acc[kt] * gc); }
#pragma unroll
        for (int r = 0; r < 4; ++r) { const int tau = 4 * q + r; const size_t mm = (size_t)g * 16 + (d ? 15 - tau : tau);
            proj[mm * N1 + 1024 + d * RW + hg * 128 + 16 * vs + n] = (bf16_t)f2bf(o[r]); }
    }
#undef GL_ISSUE
    SCAN_WAIT_V(0);
    if (!sample) { float* os = (d ? os_b : os_f) + (size_t)(b * GH + hg) * 64 * 128 + 16 * vs + n;
#pragma unroll
        for (int kt = 0; kt < 4; ++kt)
#pragma unroll
            for (int r = 0; r < 4; ++r) os[(size_t)(16 * kt + 4 * q + r) * 128] = acc[kt][r]; }
}


enum { PH_P0 = 0, PH_NORM1, PH_GEMM1, PH_PREP, PH_SCAN, PH_COMB, PH_GOUT, PH_NORM2, PH_MLP1, PH_MLP2, PH_FINAL, PH_END };
struct Args { const float* in[36]; float* out; unsigned char* ws; int ph_lo, ph_hi, li, pad; };

__global__ void __launch_bounds__(NWAVES * 64, 2) mega_fwd(Args args) {
    extern __shared__ __attribute__((aligned(16))) unsigned char lds_raw[];
    LAS unsigned char* lds = (LAS unsigned char*)lds_raw;
    volatile LAS unsigned* MISC = (volatile LAS unsigned*)(lds + MISC_OFF);
    const int tid = threadIdx.x, lane = tid & 63, wave = __builtin_amdgcn_readfirstlane(tid >> 6);
    const int G = gridDim.x, bx = blockIdx.x; const int vcu = (G % 8 == 0) ? (bx % 8) * (G / 8) + bx / 8 : bx;
    const int gw = vcu * NWAVES + wave, NGW = G * NWAVES;
    unsigned char* ws = args.ws; float* outf = args.out; unsigned char* dout = (unsigned char*)args.out;
    for (int u = tid; u < (LDS_BYTES - LDSCTL_OFF) / 4; u += NWAVES * 64) ((LAS unsigned*)(lds + LDSCTL_OFF))[u] = 0u;
    __syncthreads();
    XcdBarrier bar = xcd_barrier_post((unsigned*)ws + CW_BAR + args.li * XCD_BAR_WORDS, MISC + 8);
    const int lo = args.ph_lo, hi = args.ph_hi;
#define IN(k) (lo <= (k) && (k) < hi)
#define SEAM(k) do { if (IN(k) && IN((k) + 1)) xcd_barrier(bar); } while (0)

    const float* x_prompt = args.in[0]; const float* x_sample = args.in[1];
    bf16_t* WC1T = (bf16_t*)(ws + WS_WC1T); bf16_t* WOT = (bf16_t*)(ws + WS_WOT); bf16_t* W1T = (bf16_t*)(ws + WS_W1T); bf16_t* W2T = (bf16_t*)(ws + WS_W2T);
    float* MOD = (float*)(ws + WS_MOD); float* MODP = (float*)(ws + WS_MODP);
    bf16_t* XN = (bf16_t*)(ws + WS_XN); bf16_t* MIX = XN; bf16_t* PROJ = (bf16_t*)(ws + WS_PROJ); bf16_t* HB = PROJ; bf16_t* XN2 = (bf16_t*)(ws + WS_R1);
    float* OS_RF = outf + (size_t)M * D; float* OS_RB = OS_RF + 524288; float* OS_GF = OS_RB + 524288; float* OS_GB = OS_GF + 524288;

    if (IN(PH_P0)) {
        LAS float* scr = (LAS float*)(lds + wave * 16384);
        constexpr int I_MOD = 96 * 4, I_IN = 16 * 96, I_FOLD = 16 * 32, I_O = 16 * 32, I_S = 16 * 4 + 32 + 1;
        constexpr int NITEMS = I_MOD + I_IN + I_FOLD + I_O + I_S;
        const SrcPlain s_in{args.in[12], 3072}, s_o{args.in[32], D};
        const SrcFold s_f{args.in[14], args.in[16], args.in[19], args.in[21], args.in[28]};
        for (int it = gw; it < NITEMS; it += NGW) {
            int r = it;
            if (r < I_MOD) { p0_mod_task(args.in[2], args.in[7], args.in[8], MODP, scr, r, lane); continue; } r -= I_MOD;
            if (r < I_IN) { p0_transpose_item(s_in, D, 96, WC1T, 0, scr, r, lane); continue; } r -= I_IN;
            if (r < I_FOLD) { p0_transpose_item(s_f, D, 32, WC1T, LA, scr, r, lane); continue; } r -= I_FOLD;
            if (r < I_O) { p0_transpose_item(s_o, D, 32, WOT, 0, scr, r, lane); continue; } r -= I_O;
            if (r < 64) { const int which = r >> 5, dd = (r >> 4) & 1; const SrcPlain s{args.in[which ? 20 : 17] + (size_t)dd * 64 * RW, RW};
                p0_transpose_item(s, 64, 16, (bf16_t*)(ws + (which ? WS_LA2T : WS_LW2T)) + (size_t)dd * RW * 64, 0, scr, r & 15, lane); continue; } r -= 64;
            if (r < 32) { const SrcPlain s{args.in[22], RW}; p0_transpose_item(s, 128, 16, (bf16_t*)(ws + WS_LG2T), 0, scr, r, lane); continue; }
            { const float* gk2 = args.in[29]; bf16_t* o = (bf16_t*)(ws + WS_LGK2T);
              for (int e = lane; e < 2 * 256 * 32; e += 64) { const int dd = e >> 13, c = (e >> 5) & 255, rk = e & 31; o[e] = rk < 16 ? (bf16_t)f2bf(gk2[((size_t)dd * 16 + rk) * GQK + c]) : (bf16_t)0; } }
        }
    }
    SEAM(PH_P0);
    if (IN(PH_NORM1)) {
        const float* ada_b = args.in[9]; const float* g1n = args.in[10];
        LAS float* TG = (LAS float*)lds; LAS float* TS_ = TG + 5 * 1024;
        for (int e = tid; e < 5 * 1024; e += NWAVES * 64) { const int b = e >> 10, c = e & 1023; float sh = ada_b[c], sc = ada_b[D + c];
#pragma unroll
            for (int ks = 0; ks < 4; ++ks) { sh += MODP[(size_t)(ks * 5 + b) * NMOD + c]; sc += MODP[(size_t)(ks * 5 + b) * NMOD + D + c]; }
            TG[e] = g1n[c] * (1.f + sc); TS_[e] = sh; }
        for (int e = bx * (NWAVES * 64) + tid; e < 5 * NMOD; e += G * NWAVES * 64) { const int b = e / NMOD, c = e % NMOD; float v = ada_b[c];
#pragma unroll
            for (int ks = 0; ks < 4; ++ks) v += MODP[(size_t)(ks * 5 + b) * NMOD + c];
            MOD[e] = v; }
        __syncthreads();
        for (int m = gw; m < M; m += NGW) { const int modi = m < M_P ? 0 : 1 + ((m - M_P) >> 11);
            norm_row_bf16(m < M_P ? x_prompt + (size_t)m * D : x_sample + (size_t)(m - M_P) * D, XN + (size_t)m * D, TG + modi * 1024, TS_ + modi * 1024, lane); }
        __syncthreads();
    }
    SEAM(PH_NORM1);
    if (IN(PH_GEMM1)) {
        pg8::Gemm g{XN, WC1T, M, N1, D}; pg8::StaticOrder S; S.init(M, N1, G, bx);
        pg8::EpiBf16<0> E{PROJ, N1};
        pg8::gemm_phase<pg8::EpiBf16<0>, pg8::StaticOrder, true, true>(lds, g, S, E);
    }
    SEAM(PH_GEMM1);
    if (IN(PH_PREP)) {
        const StageAW W{args.in[13], args.in[15], args.in[18], args.in[23], args.in[24], args.in[25], args.in[30],
                        (const bf16_t*)(ws + WS_LW2T), (const bf16_t*)(ws + WS_LA2T), (const bf16_t*)(ws + WS_LG2T), (const bf16_t*)(ws + WS_LGK2T)};
        for (int g = vcu; g < NGRP; g += G) {
            __syncthreads();
            stageA_lora(g, PROJ, lds, tid);
            __syncthreads();
            stageA_unit(g, wave, PROJ, W, lds, lds + 16384 + wave * SCR_A, ws, dout, lane, args.pad == 0);
        }
    }
    SEAM(PH_PREP);
    if (IN(PH_SCAN)) {
        const float *srf = args.in[3], *srb = args.in[4], *sgf = args.in[5], *sgb = args.in[6];
        if (bx < 64) { if (wave < 4) rwkv_scan_ring<8>(256 + bx, lds, ws, dout, PROJ, srf, srb, OS_RF, OS_RB, wave, lane); else scan_idle(L_S / 16); }
        else if (bx < 96) gla_scan_ring<8>(128 + (bx - 64), lds, ws, dout, PROJ, sgf, sgb, OS_GF, OS_GB, wave, lane);
        else { const int nw = G - 96;
            for (int s = bx - 96; s < 256; s += nw) {
                if (s < 128) rwkv_scan_ring<4>(2 * s + (wave >> 2), lds + (wave >> 2) * (4 * RSLOT), ws, dout, PROJ, srf, srb, OS_RF, OS_RB, wave & 3, lane);
                else gla_scan_ring<4>(s - 128, lds, ws, dout, PROJ, sgf, sgb, OS_GF, OS_GB, wave, lane); } }
    }
    SEAM(PH_SCAN);
    if (IN(PH_COMB)) {
        const float* lnx_g = args.in[26]; const float* lnx_b = args.in[27]; const float* gla_g = args.in[31];
        const f32x4 lg0 = *(const f32x4*)(lnx_g + lane * 8), lg1 = *(const f32x4*)(lnx_g + lane * 8 + 4), lb0 = *(const f32x4*)(lnx_b + lane * 8), lb1 = *(const f32x4*)(lnx_b + lane * 8 + 4);
        const f32x4 gn0 = *(const f32x4*)(gla_g + ((lane * 8) & 127)), gn1 = *(const f32x4*)(gla_g + ((lane * 8) & 127) + 4);
        for (int m = gw; m < M; m += NGW) {
            const bf16_t* row = PROJ + (size_t)m * N1;
            const u32x4_t yf = *(const u32x4_t*)(row + lane * 8), yb = *(const u32x4_t*)(row + RW + lane * 8), of = *(const u32x4_t*)(row + 1024 + lane * 8), ob = *(const u32x4_t*)(row + 1536 + lane * 8);
            const u32x4_t gt = *(const u32x4_t*)(row + C_GATE + lane * 8), gg = *(const u32x4_t*)(row + C_GG + lane * 8), bg = *(const u32x4_t*)(dout + DO_BG + ((size_t)m * RW + lane * 8) * 2);
            f32x4 y0 = bf4_to_f32((u32x2){yf.x, yf.y}) + bf4_to_f32((u32x2){yb.x, yb.y}), y1 = bf4_to_f32((u32x2){yf.z, yf.w}) + bf4_to_f32((u32x2){yb.z, yb.w});
            float s1 = (y0[0] + y0[1]) + (y0[2] + y0[3]) + (y1[0] + y1[1]) + (y1[2] + y1[3]);
            s1 += __shfl_xor(s1, 1); s1 += __shfl_xor(s1, 2); s1 += __shfl_xor(s1, 4);
            const float mu = s1 * (1.f / 64.f); y0 = y0 - mu; y1 = y1 - mu;
            float s2 = (y0[0] * y0[0] + y0[1] * y0[1]) + (y0[2] * y0[2] + y0[3] * y0[3]) + (y1[0] * y1[0] + y1[1] * y1[1]) + (y1[2] * y1[2] + y1[3] * y1[3]);
            s2 += __shfl_xor(s2, 1); s2 += __shfl_xor(s2, 2); s2 += __shfl_xor(s2, 4);
            const float rs = rsqrtf(s2 * (1.f / 64.f) + 64e-5f);
            const f32x4 r0 = (y0 * rs * lg0 + lb0) * bf4_to_f32((u32x2){gt.x, gt.y}) + bf4_to_f32((u32x2){bg.x, bg.y});
            const f32x4 r1 = (y1 * rs * lg1 + lb1) * bf4_to_f32((u32x2){gt.z, gt.w}) + bf4_to_f32((u32x2){bg.z, bg.w});
            const u32x2 w0 = f32_to_bf4(r0), w1 = f32_to_bf4(r1);
            *(u32x4_t*)(MIX + (size_t)m * D + lane * 8) = (u32x4_t){w0.x, w0.y, w1.x, w1.y};
            const f32x4 o0 = bf4_to_f32((u32x2){of.x, of.y}) + bf4_to_f32((u32x2){ob.x, ob.y}), o1 = bf4_to_f32((u32x2){of.z, of.w}) + bf4_to_f32((u32x2){ob.z, ob.w});
            float q2 = (o0[0] * o0[0] + o0[1] * o0[1]) + (o0[2] * o0[2] + o0[3] * o0[3]) + (o1[0] * o1[0] + o1[1] * o1[1]) + (o1[2] * o1[2] + o1[3] * o1[3]);
            q2 += __shfl_xor(q2, 1); q2 += __shfl_xor(q2, 2); q2 += __shfl_xor(q2, 4); q2 += __shfl_xor(q2, 8);
            const float rq = rsqrtf(q2 * (1.f / 128.f) + 1e-5f);
            const f32x4 g0 = bf4_to_f32((u32x2){gg.x, gg.y}), g1 = bf4_to_f32((u32x2){gg.z, gg.w}); f32x4 e0, e1;
#pragma unroll
            for (int j = 0; j < 4; ++j) { e0[j] = o0[j] * rq * gn0[j] * (g0[j] * sigmoidf_(g0[j])); e1[j] = o1[j] * rq * gn1[j] * (g1[j] * sigmoidf_(g1[j])); }
            const u32x2 v0 = f32_to_bf4(e0), v1 = f32_to_bf4(e1);
            *(u32x4_t*)(MIX + (size_t)m * D + RW + lane * 8) = (u32x4_t){v0.x, v0.y, v1.x, v1.y};
        }
    }
    SEAM(PH_COMB);
    if (IN(PH_GOUT)) {
        pg8::Gemm g{MIX, WOT, M, D, D}; pg8::StaticOrder S; S.init(M, D, G, bx);
        pg8::EpiGateRes E{x_prompt, x_sample, M_P, outf, MOD, 2 * D};
        pg8::gemm_phase<pg8::EpiGateRes, pg8::StaticOrder, false, true>(lds, g, S, E);
    }
    SEAM(PH_GOUT);
    if (IN(PH_NORM2)) {
        {   LAS float* scr = (LAS float*)(lds + 40960 + wave * 8704);
            constexpr int I_1 = 16 * 128, I_2 = 64 * 32;
            const SrcPlain s_1{args.in[33], FF}, s_2{args.in[34], D};
            for (int it = gw; it < I_1 + I_2; it += NGW) { if (it < I_1) p0_transpose_item(s_1, D, 128, W1T, 0, scr, it, lane); else p0_transpose_item(s_2, FF, 32, W2T, 0, scr, it - I_1, lane); } }
        const float* g2n = args.in[11];
        LAS float* TG = (LAS float*)lds; LAS float* TS_ = TG + 5 * 1024;
        for (int e = tid; e < 5 * 1024; e += NWAVES * 64) { const int b = e >> 10, c = e & 1023; TG[e] = g2n[c] * (1.f + MOD[(size_t)b * NMOD + 4 * D + c]); TS_[e] = MOD[(size_t)b * NMOD + 3 * D + c]; }
        __syncthreads();
        for (int m = gw; m < M; m += NGW) { const int modi = m < M_P ? 0 : 1 + ((m - M_P) >> 11);
            norm_row_bf16(outf + (size_t)m * D, XN2 + (size_t)m * D, TG + modi * 1024, TS_ + modi * 1024, lane); }
        __syncthreads();
    }
    SEAM(PH_NORM2);
    if (IN(PH_MLP1)) {
        pg8::Gemm g{XN2, W1T, M, FF, D}; pg8::StaticOrder S; S.init(M, FF, G, bx);
        pg8::EpiBf16<2> E{HB, FF};
        pg8::gemm_phase<pg8::EpiBf16<2>, pg8::StaticOrder, true, true>(lds, g, S, E);
    }
    SEAM(PH_MLP1);
    if (IN(PH_MLP2)) {
        pg8::Gemm g{HB, W2T, M, D, FF}; pg8::StaticOrder S; S.init(M, D, G, bx);
        pg8::EpiGateRes E{outf, outf, M, outf, MOD, 5 * D};
        pg8::gemm_phase<pg8::EpiGateRes, pg8::StaticOrder, false, true>(lds, g, S, E);
    }
    SEAM(PH_MLP2);
    if (IN(PH_FINAL)) {
        const float* gf = args.in[35];
        f32x4 gv[4];
#pragma unroll
        for (int j = 0; j < 4; ++j) gv[j] = *((const f32x4*)gf + lane + 64 * j);
        for (int m = gw; m < M; m += NGW) { f32x4* xr = (f32x4*)(outf + (size_t)m * D) + lane; f32x4 v[4]; float s = 0.f;
#pragma unroll
            for (int j = 0; j < 4; ++j) { v[j] = xr[64 * j]; s += (v[j].x * v[j].x + v[j].y * v[j].y) + (v[j].z * v[j].z + v[j].w * v[j].w); }
            const float rs = rsqrtf(wave_sum(s) * (1.f / D) + 1e-6f);
#pragma unroll
            for (int j = 0; j < 4; ++j) xr[64 * j] = v[j] * rs * gv[j]; }
    }
#undef IN
#undef SEAM
}

#ifndef N_LAUNCHES
#define N_LAUNCHES 1
#endif
extern "C" void kernel_launch(void* const* d_in, const int* in_sizes, int n_in, void* d_out, int out_size, void* d_ws, size_t ws_size, hipStream_t stream) {
    static int grid = 0;
    if (grid == 0) {
        int dev = 0, cus = 0;
        if (hipGetDevice(&dev) != hipSuccess || hipDeviceGetAttribute(&cus, hipDeviceAttributeMultiprocessorCount, dev) != hipSuccess) { fprintf(stderr, "kernel_launch: device query failed\n"); grid = -1; return; }
        if (hipFuncSetAttribute((const void*)mega_fwd, hipFuncAttributeMaxDynamicSharedMemorySize, LDS_BYTES) != hipSuccess) { fprintf(stderr, "kernel_launch: hipFuncSetAttribute failed\n"); grid = -1; return; }
        int per_cu = 0;
        if (hipOccupancyMaxActiveBlocksPerMultiprocessor(&per_cu, (const void*)mega_fwd, NWAVES * 64, LDS_BYTES) != hipSuccess || per_cu < 1) fprintf(stderr, "kernel_launch: occupancy query reports %d\n", per_cu);
        (void)hipGetLastError();
        grid = cus;
    }
    if (grid < 0) return;
    (void)hipMemsetAsync(d_ws, 0, CTL_ZERO_BYTES, stream);
    Args a{};
    for (int i = 0; i < 36; ++i) a.in[i] = (const float*)d_in[i];
    a.out = (float*)d_out; a.ws = (unsigned char*)d_ws;
#if defined(PROBE_PHASE)
    {
        int li = 0;
        a.ph_lo = PH_P0; a.ph_hi = PROBE_PHASE; a.li = li++; if (a.ph_hi > a.ph_lo) hipLaunchKernelGGL(mega_fwd, dim3(grid), dim3(NWAVES * 64), LDS_BYTES, stream, a);
        for (int r = 0; r < PROBE_REPS; ++r) { a.ph_lo = PROBE_PHASE; a.ph_hi = PROBE_PHASE + 1; a.li = li++; a.pad = (r + 1 < PROBE_REPS) ? 1 : 0; hipLaunchKernelGGL(mega_fwd, dim3(grid), dim3(NWAVES * 64), LDS_BYTES, stream, a); }
        a.pad = 0; a.ph_lo = PROBE_PHASE + 1; a.ph_hi = PH_END; a.li = li++; if (a.ph_hi > a.ph_lo) hipLaunchKernelGGL(mega_fwd, dim3(grid), dim3(NWAVES * 64), LDS_BYTES, stream, a);
        return; }
#endif
    if (N_LAUNCHES == 1) { a.ph_lo = PH_P0; a.ph_hi = PH_END; a.li = 0; hipLaunchKernelGGL(mega_fwd, dim3(grid), dim3(NWAVES * 64), LDS_BYTES, stream, a); }
    else for (int ph = 0; ph < PH_END; ++ph) { a.ph_lo = ph; a.ph_hi = ph + 1; a.li = 0; hipLaunchKernelGGL(mega_fwd, dim3(grid), dim3(NWAVES * 64), LDS_BYTES, stream, a); }
}
```
